# Optimizing an MI355X kernel written in HIP

```python
import jax, jax.numpy as jnp
from jax import lax
import numpy as np

D_MODEL = 1024
BATCH = 32
SEQ = 2048
DEPTH = 4

CHUNK = 64
EPS = 1e-6
Q_BLOCK = 128

POOL_WINDOWS = (2, 4, 8, 16)
POOL_GROUPS = len(POOL_WINDOWS)
POOL_GROUP_DIM = D_MODEL // 16
POOL_WIDTH = POOL_GROUPS * POOL_GROUP_DIM
SB_HEADS = 8
SB_HEAD_DIM = D_MODEL // 16
SB_WIDTH = SB_HEADS * SB_HEAD_DIM
CONV_K = 3
CONV_WIDTH = D_MODEL // 4
N_BRANCH = 3
D_FF = ((8 * D_MODEL // 3 + 255) // 256) * 256

OFF_POOL = 0
OFF_Q = OFF_POOL + POOL_WIDTH
OFF_K = OFF_Q + SB_WIDTH
OFF_V = OFF_K + SB_WIDTH
OFF_CX = OFF_V + SB_WIDTH
OFF_CB = OFF_CX + CONV_WIDTH
OFF_CC = OFF_CB + CONV_WIDTH
OFF_GATE = OFF_CC + CONV_WIDTH
IN_WIDTH = OFF_GATE + N_BRANCH * D_MODEL

kernel_name = "hybrid_pool_stickbreak_shortconv_macaron"


def _rmsnorm(x, g):
    x32 = x.astype(jnp.float32)
    y = x32 * lax.rsqrt(jnp.mean(x32 * x32, axis=-1, keepdims=True) + EPS)
    return (y * g.astype(jnp.float32)).astype(x.dtype)


def _swiglu(h, w_gate, w_up, w_down):
    return (jax.nn.silu(h @ w_gate) * (h @ w_up)) @ w_down


def _pool_mixer(u, w_mix, scale):
    b, s, _ = u.shape
    ug = u.reshape(b, s, POOL_GROUPS, POOL_GROUP_DIM)
    count = jnp.arange(1, s + 1, dtype=jnp.float32)
    outs = []
    for g, w in enumerate(POOL_WINDOWS):
        ui = ug[:, :, g].astype(jnp.float32)
        cs = jnp.cumsum(ui, axis=1)
        lag = jnp.pad(cs, ((0, 0), (w, 0), (0, 0)))[:, :s]
        mean = (cs - lag) / jnp.minimum(count, float(w))[None, :, None]
        outs.append(mean - ui)
    pooled = jnp.stack(outs, axis=2).astype(u.dtype)
    mixed = jnp.einsum('bsgc,gcd->bsgd', pooled, w_mix).reshape(b, s, POOL_WIDTH)
    return mixed * scale


def _stick_breaking(q, k, v):
    s = q.shape[1]
    scale = SB_HEAD_DIM ** -0.5
    outs = []
    for i in range(s // Q_BLOCK):
        q0 = i * Q_BLOCK
        klen = q0 + Q_BLOCK
        qb = q[:, q0:klen]
        kb = k[:, :klen]
        vb = v[:, :klen]
        z = jnp.einsum('bqhd,bkhd->bhqk', qb, kb).astype(jnp.float32) * scale
        qpos = q0 + jnp.arange(Q_BLOCK)
        kpos = jnp.arange(klen)
        mask = kpos[None, :] < qpos[:, None]
        log_beta = jax.nn.log_sigmoid(z)
        log_keep = jnp.where(mask, jax.nn.log_sigmoid(-z), 0.0)
        between = lax.cumsum(log_keep, axis=3, reverse=True) - log_keep
        wts = jnp.where(mask, jnp.exp(log_beta + between), 0.0)
        outs.append(jnp.einsum('bhqk,bkhd->bqhd', wts.astype(v.dtype), vb))
    return jnp.concatenate(outs, axis=1)


def _short_conv(xc, gb, gc, conv_w, conv_b):
    s = xc.shape[1]
    u = gc * xc
    up = jnp.pad(u, ((0, 0), (CONV_K - 1, 0), (0, 0)))
    y = conv_b + sum(conv_w[j] * up[:, j:j + s] for j in range(CONV_K))
    return gb * y


def _mixing(h, w_in, b_gate, pool_w, pool_scale, conv_w, conv_b,
            w_br_pool, w_br_sb, w_br_conv, w_out):
    b, s, _ = h.shape
    p = h @ w_in
    a_out = _pool_mixer(p[..., OFF_POOL:OFF_Q], pool_w, pool_scale)
    q = p[..., OFF_Q:OFF_K].reshape(b, s, SB_HEADS, SB_HEAD_DIM)
    k = p[..., OFF_K:OFF_V].reshape(b, s, SB_HEADS, SB_HEAD_DIM)
    v = p[..., OFF_V:OFF_CX].reshape(b, s, SB_HEADS, SB_HEAD_DIM)
    b_out = _stick_breaking(q, k, v).reshape(b, s, SB_WIDTH)
    c_out = _short_conv(p[..., OFF_CX:OFF_CB], p[..., OFF_CB:OFF_CC], p[..., OFF_CC:OFF_GATE],
                        conv_w, conv_b)
    gates = jax.nn.sigmoid(p[..., OFF_GATE:].reshape(b, s, N_BRANCH, D_MODEL) + b_gate)
    merged = (gates[:, :, 0] * (a_out @ w_br_pool)
              + gates[:, :, 1] * (b_out @ w_br_sb)
              + gates[:, :, 2] * (c_out @ w_br_conv))
    return merged @ w_out


def setup_inputs(seed: int = 0) -> dict:
    key = jax.random.key(seed)
    ks = iter(jax.random.split(key, 32))
    f32 = jnp.float32

    def nrm(shape, fan_in):
        return jax.random.normal(next(ks), shape, f32) * (fan_in ** -0.5)

    def gain(shape):
        return 1.0 + 0.05 * jax.random.normal(next(ks), shape, f32)

    def small(shape):
        return 0.01 * jax.random.normal(next(ks), shape, f32)

    L, D = DEPTH, D_MODEL
    return {
        "x": jax.random.normal(next(ks), (BATCH, SEQ, D), f32),
        "ffn1_pre_g": gain((L, D)),
        "ffn1_post_g": gain((L, D)),
        "ffn1_w_gate": nrm((L, D, D_FF), D),
        "ffn1_w_up": nrm((L, D, D_FF), D),
        "ffn1_w_down": nrm((L, D_FF, D), D_FF),
        "mix_pre_g": gain((L, D)),
        "mix_post_g": gain((L, D)),
        "w_in": nrm((L, D, IN_WIDTH), D),
        "b_gate": small((L, N_BRANCH, D)),
        "pool_w": nrm((L, POOL_GROUPS, POOL_GROUP_DIM, POOL_GROUP_DIM), POOL_GROUP_DIM),
        "pool_scale": gain((L, POOL_WIDTH)),
        "conv_w": nrm((L, CONV_K, CONV_WIDTH), CONV_K),
        "conv_b": small((L, CONV_WIDTH)),
        "w_br_pool": nrm((L, POOL_WIDTH, D), POOL_WIDTH),
        "w_br_sb": nrm((L, SB_WIDTH, D), SB_WIDTH),
        "w_br_conv": nrm((L, CONV_WIDTH, D), CONV_WIDTH),
        "w_out": nrm((L, D, D), D),
        "ffn2_pre_g": gain((L, D)),
        "ffn2_post_g": gain((L, D)),
        "ffn2_w_gate": nrm((L, D, D_FF), D),
        "ffn2_w_up": nrm((L, D, D_FF), D),
        "ffn2_w_down": nrm((L, D_FF, D), D_FF),
    }


def reference(x, ffn1_pre_g, ffn1_post_g, ffn1_w_gate, ffn1_w_up, ffn1_w_down,
              mix_pre_g, mix_post_g, w_in, b_gate, pool_w, pool_scale, conv_w, conv_b,
              w_br_pool, w_br_sb, w_br_conv, w_out,
              ffn2_pre_g, ffn2_post_g, ffn2_w_gate, ffn2_w_up, ffn2_w_down):
    for l in range(DEPTH):
        h = _swiglu(_rmsnorm(x, ffn1_pre_g[l]), ffn1_w_gate[l], ffn1_w_up[l], ffn1_w_down[l])
        x = x + 0.5 * _rmsnorm(h, ffn1_post_g[l])
        h = _mixing(_rmsnorm(x, mix_pre_g[l]), w_in[l], b_gate[l], pool_w[l], pool_scale[l],
                    conv_w[l], conv_b[l], w_br_pool[l], w_br_sb[l], w_br_conv[l], w_out[l])
        x = x + _rmsnorm(h, mix_post_g[l])
        h = _swiglu(_rmsnorm(x, ffn2_pre_g[l]), ffn2_w_gate[l], ffn2_w_up[l], ffn2_w_down[l])
        x = x + 0.5 * _rmsnorm(h, ffn2_post_g[l])
    return x
```

```cpp
#include <hip/hip_runtime.h>
#include <hip/hip_cooperative_groups.h>
#include <cstdio>
#include <cstdint>
namespace cg = cooperative_groups;

#ifndef MULTI_LAUNCH
#define MULTI_LAUNCH 0
#endif

#define LAS __attribute__((address_space(3)))
typedef unsigned short bf16_t;
typedef short bf16x8 __attribute__((ext_vector_type(8)));
typedef float f32x4 __attribute__((ext_vector_type(4)));
typedef float f32x16 __attribute__((ext_vector_type(16)));
typedef unsigned u32x4 __attribute__((ext_vector_type(4)));
typedef unsigned u32x2 __attribute__((ext_vector_type(2)));

constexpr int DM = 1024, NBATCH = 32, SEQ = 2048, DEPTH = 4, MTOK = NBATCH * SEQ;
constexpr int FF = 2816, INW = 5632, NHEAD = 8, HD = 64;
constexpr int OFF_Q = 256, OFF_K = 768, OFF_V = 1280, OFF_CX = 1792, OFF_CB = 2048, OFF_CC = 2304, OFF_GATE = 2560;
constexpr float EPS = 1e-6f;
constexpr float LOG2E = 1.4426950408889634f, LN2 = 0.6931471805599453f;

constexpr size_t MiB = 1u << 20;
constexpr size_t W_GU1 = 0, W_D1 = W_GU1 + (size_t)INW * DM * 2, W_IN = W_D1 + (size_t)DM * FF * 2, W_BR = W_IN + (size_t)INW * DM * 2,
                 W_OUT = W_BR + (size_t)DM * DM * 2, W_GU2 = W_OUT + (size_t)DM * DM * 2, W_D2 = W_GU2 + (size_t)INW * DM * 2, W_END = W_D2 + (size_t)DM * FF * 2;
static_assert(W_END == 48 * MiB, "weights region");
constexpr size_t WS_XB = 48 * MiB;
constexpr size_t WS_BR = 176 * MiB;
constexpr size_t WS_P = 304 * MiB;
constexpr size_t WS_HRAW = WS_P + 352 * MiB;
constexpr size_t WS_NEED = WS_P + 704 * MiB;

__device__ __forceinline__ unsigned cvt_pk_bf16(float lo, float hi) { unsigned r; asm volatile("v_cvt_pk_bf16_f32 %0, %1, %2" : "=v"(r) : "v"(lo), "v"(hi)); return r; }
__device__ __forceinline__ float bf_lo(unsigned w) { return __uint_as_float(w << 16); }
__device__ __forceinline__ float bf_hi(unsigned w) { return __uint_as_float(w & 0xffff0000u); }
__device__ __forceinline__ float bf2f(bf16_t b) { return __uint_as_float((unsigned)b << 16); }
__device__ __forceinline__ float fast_sigmoid(float x) { return __builtin_amdgcn_rcpf(1.0f + __builtin_amdgcn_exp2f(-x * LOG2E)); }
__device__ __forceinline__ float wave_sum(float v) {
#pragma unroll
    for (int o = 1; o < 64; o <<= 1) v += __shfl_xor(v, o);
    return v;
}

namespace pg8 {
constexpr int BM = 256, BK = 64, HALF = 128, HTB = HALF * BK * 2, STAGE_BYTES = 8 * HTB, NXCD = 8, WGM = 8;
__host__ __device__ __forceinline__ int lds_byte(int r, int c) { const int st = (r >> 4) * 2 + (c >> 5), rr = r & 15, cc = c & 31, ob = rr * 64 + cc * 2; return st * 1024 + (ob ^ (((ob >> 9) & 1) << 5)); }
__host__ __device__ __forceinline__ void stage_rc(int b, int& R, int& C) { const int st = b / 1024, sb = b % 1024, swz = sb ^ (((sb >> 9) & 1) << 5); R = (st >> 1) * 16 + swz / 64; C = (st & 1) * 32 + (swz % 64) / 2; }
__host__ __device__ __forceinline__ int perm32(int rho) { const int n = rho >> 4, i = rho & 15; return 8 * (i >> 2) + 4 * n + (i & 3); }

struct Unit { int pm, pn; };
struct Gemm { const bf16_t* A; const bf16_t* Bt; int M, N, K; };

struct StaticOrder {
    int nM, nN, nwg, G, c;
    __device__ void init(int M, int N, int G_, int c_) { nM = M / BM; nN = N / BM; nwg = nM * nN; G = G_; c = c_; }
    __device__ bool next(int i, Unit& u) const {
        const long L = (long)i * G + c; if (L >= nwg) return false;
        int wgid = (int)L; { const int q = nwg / NXCD, r = nwg % NXCD, xcd = wgid % NXCD, off = wgid / NXCD; wgid = (xcd < r ? xcd * (q + 1) : r * (q + 1) + (xcd - r) * q) + off; }
        const int nig = WGM * nN, gid = wgid / nig, fm = gid * WGM, gsz = (nM - fm) < WGM ? (nM - fm) : WGM;
        u.pm = fm + ((wgid % nig) % gsz); u.pn = (wgid % nig) / gsz; return true;
    }
};

typedef f32x4 Acc[2][2][4][2];

struct EpiSwiglu {
    static constexpr bool PERM = true, HOOK = false;
    bf16_t* O;
    __device__ __forceinline__ void hook(Acc&, const Unit&, int, int, int, int, int) const {}
    __device__ __forceinline__ void operator()(Acc& acc, const Unit& u, int wr, int wc, int fr, int fq) const {
        const int row0 = u.pm * BM + wr * 64 + fr, col0 = u.pn * 128 + wc * 32 + 8 * fq;
#pragma unroll
        for (int ai = 0; ai < 2; ++ai)
#pragma unroll
            for (int m = 0; m < 4; ++m) {
                bf16_t* rowp = O + (size_t)(row0 + ai * HALF + m * 16) * FF + col0;
                float h[8];
#pragma unroll
                for (int n = 0; n < 2; ++n)
#pragma unroll
                    for (int j = 0; j < 4; ++j) { const float g = acc[ai][0][m][n][j], up = acc[ai][1][m][n][j]; h[n * 4 + j] = g * fast_sigmoid(g) * up; }
                u32x4 w; w.x = cvt_pk_bf16(h[0], h[1]); w.y = cvt_pk_bf16(h[2], h[3]); w.z = cvt_pk_bf16(h[4], h[5]); w.w = cvt_pk_bf16(h[6], h[7]);
                *(u32x4*)rowp = w;
            }
    }
};
struct EpiF32 {
    static constexpr bool PERM = false, HOOK = false;
    float* O;
    __device__ __forceinline__ void hook(Acc&, const Unit&, int, int, int, int, int) const {}
    __device__ __forceinline__ void operator()(Acc& acc, const Unit& u, int wr, int wc, int fr, int fq) const {
        const int row0 = u.pm * BM + wr * 64 + fr, col0 = u.pn * BM + wc * 32 + 4 * fq;
#pragma unroll
        for (int ai = 0; ai < 2; ++ai)
#pragma unroll
            for (int m = 0; m < 4; ++m) {
                float* rowp = O + (size_t)(row0 + ai * HALF + m * 16) * DM + col0;
#pragma unroll
                for (int bj = 0; bj < 2; ++bj)
#pragma unroll
                    for (int n = 0; n < 2; ++n) *(f32x4*)(rowp + bj * HALF + n * 16) = acc[ai][bj][m][n];
            }
    }
};
struct EpiMix {
    static constexpr bool PERM = true, HOOK = false;
    bf16_t* O; const float* bgate;
    __device__ __forceinline__ void hook(Acc&, const Unit&, int, int, int, int, int) const {}
    __device__ __forceinline__ void operator()(Acc& acc, const Unit& u, int wr, int wc, int fr, int fq) const {
        const int row0 = u.pm * BM + wr * 64 + fr, col0 = u.pn * BM + wc * 32 + 8 * fq;
        const bool gate = u.pn >= 10;
        f32x4 bv[2][2];
#pragma unroll
        for (int bj = 0; bj < 2; ++bj)
#pragma unroll
            for (int n = 0; n < 2; ++n) bv[bj][n] = gate ? *(const f32x4*)(bgate + (col0 - OFF_GATE) + bj * HALF + 4 * n) : (f32x4){0.f, 0.f, 0.f, 0.f};
#pragma unroll
        for (int ai = 0; ai < 2; ++ai)
#pragma unroll
            for (int m = 0; m < 4; ++m) {
                bf16_t* rowp = O + (size_t)(row0 + ai * HALF + m * 16) * INW + col0;
#pragma unroll
                for (int bj = 0; bj < 2; ++bj) {
                    f32x4 v0 = acc[ai][bj][m][0], v1 = acc[ai][bj][m][1];
                    if (gate) {
                        v0 = v0 + bv[bj][0]; v1 = v1 + bv[bj][1];
#pragma unroll
                        for (int j = 0; j < 4; ++j) { v0[j] = fast_sigmoid(v0[j]); v1[j] = fast_sigmoid(v1[j]); }
                    }
                    u32x4 w; w.x = cvt_pk_bf16(v0[0], v0[1]); w.y = cvt_pk_bf16(v0[2], v0[3]); w.z = cvt_pk_bf16(v1[0], v1[1]); w.w = cvt_pk_bf16(v1[2], v1[3]);
                    *(u32x4*)(rowp + bj * HALF) = w;
                }
            }
    }
};
struct EpiMerged {
    static constexpr bool PERM = true, HOOK = true;
    bf16_t* O; const bf16_t* G;
    __device__ __forceinline__ void hook(Acc& acc, const Unit& u, int wr, int wc, int fr, int fq, int which) const {
        int row0 = u.pm * BM + wr * 64 + fr, col0 = u.pn * BM + wc * 32 + 8 * fq;
        asm volatile("" : "+v"(row0), "+v"(col0));
#pragma unroll
        for (int ai = 0; ai < 2; ++ai)
#pragma unroll
            for (int m = 0; m < 4; ++m) {
                const bf16_t* gp = G + (size_t)(row0 + ai * HALF + m * 16) * INW + which * DM + col0;
#pragma unroll
                for (int bj = 0; bj < 2; ++bj) {
                    const u32x4 a = *(const u32x4*)(gp + bj * HALF), b = *(const u32x4*)(gp + DM + bj * HALF);
                    float r[8];
#pragma unroll
                    for (int j = 0; j < 4; ++j) {
                        r[2 * j] = bf_lo(a[j]) * __builtin_amdgcn_rcpf(fmaxf(bf_lo(b[j]), 1e-30f));
                        r[2 * j + 1] = bf_hi(a[j]) * __builtin_amdgcn_rcpf(fmaxf(bf_hi(b[j]), 1e-30f));
                    }
#pragma unroll
                    for (int j = 0; j < 4; ++j) { acc[ai][bj][m][0][j] *= r[j]; acc[ai][bj][m][1][j] *= r[4 + j]; }
                }
                asm volatile("" ::: "memory");
            }
    }
    __device__ __forceinline__ void operator()(Acc& acc, const Unit& u, int wr, int wc, int fr, int fq) const {
        const int row0 = u.pm * BM + wr * 64 + fr, col0 = u.pn * BM + wc * 32 + 8 * fq;
#pragma unroll
        for (int ai = 0; ai < 2; ++ai)
#pragma unroll
            for (int m = 0; m < 4; ++m) {
                const size_t row = (size_t)(row0 + ai * HALF + m * 16);
                const bf16_t* gp = G + row * INW + 2 * DM + col0;
                bf16_t* rowp = O + row * DM + col0;
#pragma unroll
                for (int bj = 0; bj < 2; ++bj) {
                    const u32x4 a = *(const u32x4*)(gp + bj * HALF);
                    const f32x4 v0 = acc[ai][bj][m][0], v1 = acc[ai][bj][m][1];
                    u32x4 w;
                    w.x = cvt_pk_bf16(v0[0] * bf_lo(a[0]), v0[1] * bf_hi(a[0])); w.y = cvt_pk_bf16(v0[2] * bf_lo(a[1]), v0[3] * bf_hi(a[1]));
                    w.z = cvt_pk_bf16(v1[0] * bf_lo(a[2]), v1[1] * bf_hi(a[2])); w.w = cvt_pk_bf16(v1[2] * bf_lo(a[3]), v1[3] * bf_hi(a[3]));
                    *(u32x4*)(rowp + bj * HALF) = w;
                }
                asm volatile("" ::: "memory");
            }
    }
};

template <class Epi>
__device__ __forceinline__ void gemm_phase(const int tid, LAS unsigned char* lds, const Gemm g, const StaticOrder& S, const Epi& E) {
    const int wid = __builtin_amdgcn_readfirstlane(tid >> 6), lane = tid & 63, wr = wid >> 2, wc = wid & 3, fr = lane & 15, fq = lane >> 4;
    const int K = g.K, nt = K / BK;
    unsigned voffA[2], voffB[2];
#pragma unroll
    for (int i = 0; i < 2; ++i) { int R, C; stage_rc(tid * 16 + i * 8192, R, C); const int Rb = Epi::PERM ? ((R & ~31) + perm32(R & 31)) : R;
        voffA[i] = (unsigned)(R * K + C) * 2u; voffB[i] = (unsigned)(Rb * K + C) * 2u; }
    const size_t kstep = (size_t)(BK * 2);
    const size_t hstep = (size_t)HALF * K * 2;
    const size_t tstep = 2 * hstep;
    const unsigned ldsw = (unsigned)wid * 1024u;
    const int aoff = lds_byte(wr * 64 + fr, fq * 8), boff = lds_byte(wc * 32 + fr, fq * 8);
#define PG8_SA(b, h) (((b) * 2 + (h)) * HTB)
#define PG8_SB(b, h) ((4 + (b) * 2 + (h)) * HTB)
#define PG8_STAGE(bufoff, gbase, voff) do { _Pragma("unroll") for (int _i = 0; _i < 2; ++_i) \
        __builtin_amdgcn_global_load_lds((const unsigned*)((const char*)(gbase) + (voff)[_i]), (LAS unsigned*)(lds + (bufoff) + ldsw + _i * 8192), 16, 0, 0); } while (0)
#define PG8_LDA(dst, b, h) do { _Pragma("unroll") for (int m = 0; m < 4; ++m) _Pragma("unroll") for (int k = 0; k < 2; ++k) dst[m][k] = *(const LAS bf16x8*)(lds + PG8_SA(b, h) + aoff + m * 2048 + k * 1024); } while (0)
#define PG8_LDB(dst, b, h) do { _Pragma("unroll") for (int n = 0; n < 2; ++n) _Pragma("unroll") for (int k = 0; k < 2; ++k) dst[n][k] = *(const LAS bf16x8*)(lds + PG8_SB(b, h) + boff + n * 2048 + k * 1024); } while (0)
#define PG8_MMA(ai, bj, At, Bt) do { __builtin_amdgcn_s_setprio(1); _Pragma("unroll") for (int m = 0; m < 4; ++m) _Pragma("unroll") for (int n = 0; n < 2; ++n) _Pragma("unroll") for (int k = 0; k < 2; ++k) \
        acc[ai][bj][m][n] = __builtin_amdgcn_mfma_f32_16x16x32_bf16(Bt[n][k], At[m][k], acc[ai][bj][m][n], 0, 0, 0); __builtin_amdgcn_s_setprio(0); } while (0)
#define PG8_WAIT_V(n) asm volatile("s_waitcnt vmcnt(" #n ")" ::: "memory")
#define PG8_WAIT_L(n) asm volatile("s_waitcnt lgkmcnt(" #n ")" ::: "memory")
#define PG8_BAR __builtin_amdgcn_s_barrier()
#define PG8_SCHED __builtin_amdgcn_sched_barrier(0)
    Unit cur, nxt; int ui = 0;
    if (!S.next(0, cur)) return;
    Acc acc;
#pragma unroll
    for (int a = 0; a < 2; ++a)
#pragma unroll
        for (int b = 0; b < 2; ++b)
#pragma unroll
            for (int m = 0; m < 4; ++m)
#pragma unroll
                for (int n = 0; n < 2; ++n) acc[a][b][m][n] = (f32x4){0.f, 0.f, 0.f, 0.f};
    bf16x8 At[4][2], B0[2][2], B1[2][2];
    const char* cA = (const char*)g.A + (size_t)cur.pm * tstep; const char* cB = (const char*)g.Bt + (size_t)cur.pn * tstep;
    PG8_STAGE(PG8_SB(0, 0), cB, voffB); PG8_STAGE(PG8_SB(0, 1), cB + hstep, voffB); PG8_STAGE(PG8_SA(0, 0), cA, voffA); PG8_STAGE(PG8_SA(0, 1), cA + hstep, voffA);
    if (wr == 1) PG8_BAR;
    PG8_WAIT_V(2); PG8_BAR;
    PG8_STAGE(PG8_SB(1, 0), cB + kstep, voffB); PG8_STAGE(PG8_SA(1, 0), cA + kstep, voffA); PG8_STAGE(PG8_SB(1, 1), cB + hstep + kstep, voffB);
    PG8_WAIT_V(6); PG8_BAR;
    for (;;) {
        const bool has_next = S.next(ui + 1, nxt);
        const char* nA = has_next ? (const char*)g.A + (size_t)nxt.pm * tstep : cA; const char* nB = has_next ? (const char*)g.Bt + (size_t)nxt.pn * tstep : cB;
        for (int t = 0; t < nt; t += 2) {
            const bool last = (t == nt - 2);
            const char* a1 = cA + (size_t)(t + 1) * kstep;
            const char* a2 = last ? nA : cA + (size_t)(t + 2) * kstep; const char* b2 = last ? nB : cB + (size_t)(t + 2) * kstep;
            const char* a3 = a2 + kstep; const char* b3 = b2 + kstep;
            PG8_LDB(B0, 0, 0); PG8_LDB(B1, 0, 1); PG8_SCHED; PG8_LDA(At, 0, 0); PG8_STAGE(PG8_SA(1, 1), a1 + hstep, voffA);
            PG8_WAIT_V(8); PG8_WAIT_L(0); PG8_BAR; PG8_MMA(0, 0, At, B0); PG8_MMA(0, 1, At, B1); PG8_BAR; PG8_SCHED;
            PG8_LDA(At, 0, 1); PG8_STAGE(PG8_SB(0, 0), b2, voffB); PG8_STAGE(PG8_SB(0, 1), b2 + hstep, voffB); PG8_STAGE(PG8_SA(0, 0), a2, voffA);
            PG8_WAIT_V(8); PG8_WAIT_L(0); PG8_BAR; PG8_MMA(1, 0, At, B0); PG8_MMA(1, 1, At, B1); PG8_BAR; PG8_SCHED;
            PG8_LDB(B0, 1, 0); PG8_LDB(B1, 1, 1); PG8_SCHED; PG8_LDA(At, 1, 0); PG8_STAGE(PG8_SA(0, 1), a2 + hstep, voffA);
            PG8_WAIT_V(8); PG8_WAIT_L(0); PG8_BAR; PG8_MMA(0, 0, At, B0); PG8_MMA(0, 1, At, B1); PG8_BAR; PG8_SCHED;
            PG8_LDA(At, 1, 1); PG8_STAGE(PG8_SB(1, 0), b3, voffB); PG8_STAGE(PG8_SB(1, 1), b3 + hstep, voffB); PG8_STAGE(PG8_SA(1, 0), a3, voffA);
            PG8_WAIT_V(8); PG8_WAIT_L(0); PG8_BAR; PG8_MMA(1, 0, At, B0); PG8_MMA(1, 1, At, B1); PG8_BAR; PG8_SCHED;
            if constexpr (Epi::HOOK) { if (t == 2 || t == 10) E.hook(acc, cur, wr, wc, fr, fq, t == 10 ? 1 : 0); PG8_SCHED; }
        }
        if (wr == 0) PG8_BAR;
        E(acc, cur, wr, wc, fr, fq);
        if (!has_next) break;
#pragma unroll
        for (int a = 0; a < 2; ++a)
#pragma unroll
            for (int b = 0; b < 2; ++b)
#pragma unroll
                for (int m = 0; m < 4; ++m)
#pragma unroll
                    for (int n = 0; n < 2; ++n) acc[a][b][m][n] = (f32x4){0.f, 0.f, 0.f, 0.f};
        cur = nxt; cA = nA; cB = nB; ++ui;
        if (wr == 1) PG8_BAR;
    }
    PG8_WAIT_V(0);
    PG8_BAR;
#undef PG8_SA
#undef PG8_SB
#undef PG8_STAGE
#undef PG8_LDA
#undef PG8_LDB
#undef PG8_MMA
#undef PG8_WAIT_V
#undef PG8_WAIT_L
#undef PG8_BAR
#undef PG8_SCHED
}
}

struct Args {
    const float* in[23];
    float* out;
    unsigned char* ws;
    int ph_lo, ph_hi;
};
enum { I_X = 0, I_F1PRE, I_F1POST, I_F1WG, I_F1WU, I_F1WD, I_MPRE, I_MPOST, I_WIN, I_BGATE, I_POOLW, I_POOLS, I_CONVW, I_CONVB,
       I_WBP, I_WBS, I_WBC, I_WOUT, I_F2PRE, I_F2POST, I_F2WG, I_F2WU, I_F2WD };

__device__ __forceinline__ void transpose_item(const float* W, int N, int k0, int n0, bf16_t* WT, int dpitch, int drow0, int dk0, float scale, float* scr, int lane) {
#pragma unroll 8
    for (int i = 0; i < 32; ++i) { const int kk = 2 * i + (lane >> 5); scr[kk * 33 + (lane & 31)] = W[(size_t)(k0 + kk) * N + n0 + (lane & 31)]; }
    asm volatile("s_waitcnt lgkmcnt(0)" ::: "memory");
    const int c = lane & 7;
#pragma unroll
    for (int j = 0; j < 4; ++j) { const int n = (lane >> 3) + 8 * j; const float* s = scr + (8 * c) * 33 + n;
        u32x4 o; o.x = cvt_pk_bf16(s[0 * 33] * scale, s[1 * 33] * scale); o.y = cvt_pk_bf16(s[2 * 33] * scale, s[3 * 33] * scale);
        o.z = cvt_pk_bf16(s[4 * 33] * scale, s[5 * 33] * scale); o.w = cvt_pk_bf16(s[6 * 33] * scale, s[7 * 33] * scale);
        *(u32x4*)(WT + (size_t)(drow0 + n) * dpitch + dk0 + 8 * c) = o; }
    asm volatile("s_waitcnt lgkmcnt(0)" ::: "memory");
}
__device__ __forceinline__ bool convert_matrix(int& r, const float* W, int K, int N, bf16_t* WT, int dpitch, int dk_off, int kind, float* scr, int lane) {
    const int nblk = N / 32, items = (K / 64) * nblk;
    if (r >= items) { r -= items; return false; }
    const int kb = r / nblk, nb = r % nblk, k0 = 64 * kb, n0 = 32 * nb;
    int drow0 = n0; float scale = 1.0f;
    if (kind == 1) drow0 = 256 * (n0 >> 7) + (n0 & 127);
    else if (kind == 2) drow0 = 256 * (n0 >> 7) + 128 + (n0 & 127);
    else if (kind == 3) scale = (n0 >= OFF_Q && n0 < OFF_K) ? 0.125f : 1.0f;
    transpose_item(W, N, k0, n0, WT, dpitch, drow0, dk_off + k0, scale, scr, lane);
    return true;
}
__device__ __forceinline__ void convert_weights(const Args& a, int l, unsigned char* ldsraw, int gw, int NGW, int wave, int lane) {
    float* scr = (float*)(ldsraw + wave * 16384);
    unsigned char* ws = a.ws;
    constexpr int NITEMS = 12288;
    const size_t gu = (size_t)l * DM * FF, dn = (size_t)l * FF * DM;
    for (int it = gw; it < NITEMS; it += NGW) {
        int r = it;
        if (convert_matrix(r, a.in[I_F1WG] + gu, DM, FF, (bf16_t*)(ws + W_GU1), DM, 0, 1, scr, lane)) continue;
        if (convert_matrix(r, a.in[I_F1WU] + gu, DM, FF, (bf16_t*)(ws + W_GU1), DM, 0, 2, scr, lane)) continue;
        if (convert_matrix(r, a.in[I_F1WD] + dn, FF, DM, (bf16_t*)(ws + W_D1), FF, 0, 0, scr, lane)) continue;
        if (convert_matrix(r, a.in[I_WIN] + (size_t)l * DM * INW, DM, INW, (bf16_t*)(ws + W_IN), DM, 0, 3, scr, lane)) continue;
        if (convert_matrix(r, a.in[I_WBP] + (size_t)l * 256 * DM, 256, DM, (bf16_t*)(ws + W_BR), DM, 0, 0, scr, lane)) continue;
        if (convert_matrix(r, a.in[I_WBS] + (size_t)l * 512 * DM, 512, DM, (bf16_t*)(ws + W_BR), DM, 256, 0, scr, lane)) continue;
        if (convert_matrix(r, a.in[I_WBC] + (size_t)l * 256 * DM, 256, DM, (bf16_t*)(ws + W_BR), DM, 768, 0, scr, lane)) continue;
        if (convert_matrix(r, a.in[I_WOUT] + (size_t)l * DM * DM, DM, DM, (bf16_t*)(ws + W_OUT), DM, 0, 0, scr, lane)) continue;
        if (convert_matrix(r, a.in[I_F2WG] + gu, DM, FF, (bf16_t*)(ws + W_GU2), DM, 0, 1, scr, lane)) continue;
        if (convert_matrix(r, a.in[I_F2WU] + gu, DM, FF, (bf16_t*)(ws + W_GU2), DM, 0, 2, scr, lane)) continue;
        convert_matrix(r, a.in[I_F2WD] + dn, FF, DM, (bf16_t*)(ws + W_D2), FF, 0, 0, scr, lane);
    }
}

__device__ __forceinline__ void norm_phase(const float* xin, float* xout, const float* h, const float* gpost, float c, const float* gpre, bf16_t* XB, int gw, int NGW, int lane) {
    f32x4 gp[4], gq[4];
#pragma unroll
    for (int j = 0; j < 4; ++j) { gp[j] = h ? ((const f32x4*)gpost)[lane + 64 * j] : (f32x4){0.f, 0.f, 0.f, 0.f}; gq[j] = gpre ? ((const f32x4*)gpre)[lane + 64 * j] : (f32x4){0.f, 0.f, 0.f, 0.f}; }
    for (int row = gw; row < MTOK; row += NGW) {
        const f32x4* xr = (const f32x4*)(xin + (size_t)row * DM) + lane;
        f32x4 x[4];
#pragma unroll
        for (int j = 0; j < 4; ++j) x[j] = xr[64 * j];
        if (h) {
            const f32x4* hr = (const f32x4*)(h + (size_t)row * DM) + lane;
            f32x4 hv[4]; float ss = 0.f;
#pragma unroll
            for (int j = 0; j < 4; ++j) { hv[j] = hr[64 * j]; ss += (hv[j].x * hv[j].x + hv[j].y * hv[j].y) + (hv[j].z * hv[j].z + hv[j].w * hv[j].w); }
            const float rinv = c * __builtin_amdgcn_rsqf(wave_sum(ss) * (1.0f / DM) + EPS);
            f32x4* orow = (f32x4*)(xout + (size_t)row * DM) + lane;
#pragma unroll
            for (int j = 0; j < 4; ++j) { x[j] = x[j] + hv[j] * gp[j] * rinv; orow[64 * j] = x[j]; }
        }
        if (gpre) {
            float s2 = 0.f;
#pragma unroll
            for (int j = 0; j < 4; ++j) s2 += (x[j].x * x[j].x + x[j].y * x[j].y) + (x[j].z * x[j].z + x[j].w * x[j].w);
            const float r2 = __builtin_amdgcn_rsqf(wave_sum(s2) * (1.0f / DM) + EPS);
            u32x2* o8 = (u32x2*)(XB + (size_t)row * DM) + lane;
#pragma unroll
            for (int j = 0; j < 4; ++j) { const f32x4 v = x[j] * gq[j] * r2; u32x2 w; w.x = cvt_pk_bf16(v.x, v.y); w.y = cvt_pk_bf16(v.z, v.w); o8[64 * j] = w; }
        }
    }
}

constexpr int KP = 72;
constexpr int ATT_TILE = 64 * KP;
__device__ __forceinline__ int crow(int i, int hi) { return (i & 3) + 8 * (i >> 2) + 4 * hi; }

__device__ __forceinline__ void attn_sub(const f32x16& z, int kbase  , int tq, bool needmask, int hi, float carry_in, float& tot_out, bf16x8& p0, bf16x8& p1) {
    float sp[16];
#pragma unroll
    for (int i = 0; i < 16; ++i) {
        const float zi = z[i];
        const float e = __builtin_amdgcn_exp2f(-fabsf(zi) * LOG2E);
        float s = fmaxf(zi, 0.f) + __builtin_amdgcn_logf(1.0f + e) * LN2;
        if (needmask && (kbase + crow(i, hi) >= tq)) s = 0.f;
        sp[i] = s;
    }
    float G[4], Gp[4];
#pragma unroll
    for (int k = 0; k < 4; ++k) { G[k] = (sp[4 * k] + sp[4 * k + 1]) + (sp[4 * k + 2] + sp[4 * k + 3]); Gp[k] = __shfl_xor(G[k], 32); }
    float run = carry_in;
    float A[16];
#pragma unroll
    for (int k = 3; k >= 0; --k) {
        const float base = run + (hi == 0 ? Gp[k] : 0.f);
        const float c3 = base + sp[4 * k + 3], c2 = c3 + sp[4 * k + 2], c1 = c2 + sp[4 * k + 1], c0 = c1 + sp[4 * k];
        A[4 * k + 3] = __builtin_amdgcn_exp2f((z[4 * k + 3] - c3) * LOG2E);
        A[4 * k + 2] = __builtin_amdgcn_exp2f((z[4 * k + 2] - c2) * LOG2E);
        A[4 * k + 1] = __builtin_amdgcn_exp2f((z[4 * k + 1] - c1) * LOG2E);
        A[4 * k + 0] = __builtin_amdgcn_exp2f((z[4 * k + 0] - c0) * LOG2E);
        run += G[k] + Gp[k];
    }
    if (needmask) {
#pragma unroll
        for (int i = 0; i < 16; ++i) if (kbase + crow(i, hi) >= tq) A[i] = 0.f;
    }
    tot_out = run - carry_in;
    u32x4 w0, w1;
    w0.x = cvt_pk_bf16(A[0], A[1]); w0.y = cvt_pk_bf16(A[2], A[3]); w0.z = cvt_pk_bf16(A[4], A[5]); w0.w = cvt_pk_bf16(A[6], A[7]);
    w1.x = cvt_pk_bf16(A[8], A[9]); w1.y = cvt_pk_bf16(A[10], A[11]); w1.z = cvt_pk_bf16(A[12], A[13]); w1.w = cvt_pk_bf16(A[14], A[15]);
    p0 = __builtin_bit_cast(bf16x8, w0); p1 = __builtin_bit_cast(bf16x8, w1);
}

__device__ __forceinline__ void attn_phase(const int tid, const int bid, const int G, unsigned char* ldsraw, const bf16_t* P, bf16_t* BR) {
    const int lane = tid & 63, r32 = lane & 31, hi = lane >> 5;
    const int wid = __builtin_amdgcn_readfirstlane(tid >> 6);
    bf16_t* Kl = (bf16_t*)ldsraw;
    bf16_t* Vl = (bf16_t*)ldsraw + 2 * ATT_TILE;
    const int skey = tid >> 3, sch = tid & 7;
    for (int u = bid; u < NBATCH * NHEAD * 8; u += G) {
        const int bh = u & 255, qb = u >> 8, b = bh >> 3, h = bh & 7;
        const size_t rowbase = (size_t)b * SEQ;
        const int q0 = qb * 256, NT = 4 * (qb + 1);
        const int tq = q0 + wid * 32 + r32;
        bf16x8 qf[4];
        { const bf16_t* Qw = P + (rowbase + tq) * INW + OFF_Q + h * HD + hi * 8;
#pragma unroll
          for (int d0 = 0; d0 < 4; ++d0) qf[d0] = *(const bf16x8*)(Qw + d0 * 16); }
        f32x16 o0 = {}, o1 = {};
        float R = 0.f;
        const bf16_t* Kg = P + (rowbase + skey) * INW + OFF_K + h * HD + sch * 8;
        const bf16_t* Vg = P + (rowbase + skey) * INW + OFF_V + h * HD + sch * 8;
        u32x4 kreg = *(const u32x4*)(Kg + (size_t)(NT - 1) * 64 * INW), vreg = *(const u32x4*)(Vg + (size_t)(NT - 1) * 64 * INW);
        for (int it = 0; it < NT; ++it) {
            const int kb = NT - 1 - it, buf = it & 1;
            bf16_t* Kb = Kl + buf * ATT_TILE; bf16_t* Vb = Vl + buf * ATT_TILE;
            *(u32x4*)(Kb + skey * KP + sch * 8) = kreg;
#pragma unroll
            for (int e = 0; e < 4; ++e) { Vb[(sch * 8 + 2 * e) * KP + skey] = (bf16_t)(vreg[e] & 0xffffu); Vb[(sch * 8 + 2 * e + 1) * KP + skey] = (bf16_t)(vreg[e] >> 16); }
            __syncthreads();
            if (it + 1 < NT) { kreg = *(const u32x4*)(Kg + (size_t)(kb - 1) * 64 * INW); vreg = *(const u32x4*)(Vg + (size_t)(kb - 1) * 64 * INW); }
            if (kb * 64 <= q0 + wid * 32 + 30) {
                const bool needmask = (kb * 64 + 63 >= q0 + wid * 32);
                f32x16 z0 = {}, z1 = {};
#pragma unroll
                for (int d0 = 0; d0 < 4; ++d0) {
                    const bf16x8 k0 = *(const bf16x8*)(Kb + r32 * KP + d0 * 16 + hi * 8);
                    const bf16x8 k1 = *(const bf16x8*)(Kb + (32 + r32) * KP + d0 * 16 + hi * 8);
                    z0 = __builtin_amdgcn_mfma_f32_32x32x16_bf16(k0, qf[d0], z0, 0, 0, 0);
                    z1 = __builtin_amdgcn_mfma_f32_32x32x16_bf16(k1, qf[d0], z1, 0, 0, 0);
                }
                bf16x8 pf[4]; float t1, t0;
                attn_sub(z1, kb * 64 + 32, tq, needmask, hi, R, t1, pf[2], pf[3]);
                attn_sub(z0, kb * 64, tq, needmask, hi, R + t1, t0, pf[0], pf[1]);
                R += t1 + t0;
#pragma unroll
                for (int s = 0; s < 4; ++s) {
                    const bf16_t* v0p = Vb + r32 * KP + 16 * s + 4 * hi;
                    const bf16_t* v1p = Vb + (32 + r32) * KP + 16 * s + 4 * hi;
                    const u32x2 a0 = *(const u32x2*)v0p, a1 = *(const u32x2*)(v0p + 8);
                    const u32x2 c0 = *(const u32x2*)v1p, c1 = *(const u32x2*)(v1p + 8);
                    const u32x4 va = {a0.x, a0.y, a1.x, a1.y}, vc = {c0.x, c0.y, c1.x, c1.y};
                    o0 = __builtin_amdgcn_mfma_f32_32x32x16_bf16(__builtin_bit_cast(bf16x8, va), pf[s], o0, 0, 0, 0);
                    o1 = __builtin_amdgcn_mfma_f32_32x32x16_bf16(__builtin_bit_cast(bf16x8, vc), pf[s], o1, 0, 0, 0);
                }
            }
        }
        bf16_t* Ow = BR + (rowbase + tq) * DM + 256 + h * HD + 4 * hi;
#pragma unroll
        for (int g = 0; g < 4; ++g) {
            u32x2 w; w.x = cvt_pk_bf16(o0[4 * g], o0[4 * g + 1]); w.y = cvt_pk_bf16(o0[4 * g + 2], o0[4 * g + 3]); *(u32x2*)(Ow + 8 * g) = w;
            u32x2 x; x.x = cvt_pk_bf16(o1[4 * g], o1[4 * g + 1]); x.y = cvt_pk_bf16(o1[4 * g + 2], o1[4 * g + 3]); *(u32x2*)(Ow + 32 + 8 * g) = x;
        }
        __syncthreads();
    }
}

__device__ __forceinline__ void pool_phase(const int tid, const int bid, const int G, unsigned char* ldsraw, const bf16_t* P, bf16_t* BR, const float* pool_w, const float* pool_scale) {
    float* U = (float*)ldsraw;
    float* Pl = U + 80 * 64;
    float* Wl = Pl + 64 * 65;
    for (int tile = bid; tile < (MTOK / 64) * 4; tile += G) {
        const int g = tile & 3, tt = tile >> 2, tok0 = tt * 64, t0 = tok0 & (SEQ - 1), w = 2 << g;
        for (int idx = tid; idx < 80 * 64; idx += 512) {
            const int r = idx >> 6, c = idx & 63, pos = t0 - 16 + r;
            U[idx] = pos >= 0 ? bf2f(P[(size_t)(tok0 - 16 + r) * INW + g * 64 + c]) : 0.f;
        }
        for (int idx = tid; idx < 64 * 64; idx += 512) Wl[idx] = pool_w[g * 4096 + idx];
        __syncthreads();
        for (int idx = tid; idx < 64 * 64; idx += 512) {
            const int t = idx >> 6, c = idx & 63;
            float s = 0.f;
            for (int j = 0; j < w; ++j) s += U[(16 + t - j) * 64 + c];
            const int cnt = (t0 + t + 1) < w ? (t0 + t + 1) : w;
            Pl[t * 65 + c] = s / (float)cnt - U[(16 + t) * 64 + c];
        }
        __syncthreads();
        {
            const int d = tid & 63, tq = tid >> 6;
            float acc[8];
#pragma unroll
            for (int i = 0; i < 8; ++i) acc[i] = 0.f;
            for (int c = 0; c < 64; ++c) {
                const float wv = Wl[c * 64 + d];
#pragma unroll
                for (int i = 0; i < 8; ++i) acc[i] += Pl[(8 * tq + i) * 65 + c] * wv;
            }
            const float sc = pool_scale[g * 64 + d];
#pragma unroll
            for (int i = 0; i < 8; ++i) BR[(size_t)(tok0 + 8 * tq + i) * DM + g * 64 + d] = (bf16_t)(cvt_pk_bf16(acc[i] * sc, 0.f) & 0xffffu);
        }
        __syncthreads();
    }
}

__device__ __forceinline__ void conv_phase(const int tid, const int bid, const int G, const bf16_t* P, bf16_t* BR, const float* conv_w, const float* conv_b) {
    for (int idx = bid * 512 + tid; idx < MTOK * 32; idx += G * 512) {
        const int row = idx >> 5, ch = (idx & 31) * 8, pos = row & (SEQ - 1);
        const bf16_t* pr = P + (size_t)row * INW;
        const u32x4 z = {0u, 0u, 0u, 0u};
        const u32x4 x0 = *(const u32x4*)(pr + OFF_CX + ch), c0 = *(const u32x4*)(pr + OFF_CC + ch), gb = *(const u32x4*)(pr + OFF_CB + ch);
        const u32x4 x1 = pos >= 1 ? *(const u32x4*)(pr - INW + OFF_CX + ch) : z, c1 = pos >= 1 ? *(const u32x4*)(pr - INW + OFF_CC + ch) : z;
        const u32x4 x2 = pos >= 2 ? *(const u32x4*)(pr - 2 * INW + OFF_CX + ch) : z, c2 = pos >= 2 ? *(const u32x4*)(pr - 2 * INW + OFF_CC + ch) : z;
        float y[8];
#pragma unroll
        for (int j = 0; j < 4; ++j) {
#pragma unroll
            for (int hh = 0; hh < 2; ++hh) {
                const int e = 2 * j + hh;
                const float u0 = hh ? bf_hi(x0[j]) * bf_hi(c0[j]) : bf_lo(x0[j]) * bf_lo(c0[j]);
                const float u1 = hh ? bf_hi(x1[j]) * bf_hi(c1[j]) : bf_lo(x1[j]) * bf_lo(c1[j]);
                const float u2 = hh ? bf_hi(x2[j]) * bf_hi(c2[j]) : bf_lo(x2[j]) * bf_lo(c2[j]);
                const float v = conv_b[ch + e] + conv_w[ch + e] * u2 + conv_w[256 + ch + e] * u1 + conv_w[512 + ch + e] * u0;
                y[e] = (hh ? bf_hi(gb[j]) : bf_lo(gb[j])) * v;
            }
        }
        u32x4 w; w.x = cvt_pk_bf16(y[0], y[1]); w.y = cvt_pk_bf16(y[2], y[3]); w.z = cvt_pk_bf16(y[4], y[5]); w.w = cvt_pk_bf16(y[6], y[7]);
        *(u32x4*)(BR + (size_t)row * DM + 768 + ch) = w;
    }
}

constexpr int LDS_BYTES = 131072 + 1024;
constexpr int NPHASE = 1 + 11 * DEPTH;

__global__ void __launch_bounds__(512, 2) fwd_megakernel(Args a) {
    extern __shared__ __attribute__((aligned(16))) unsigned char lds[];
    cg::grid_group grid = cg::this_grid();
    const int G = gridDim.x, NGW = G * 8;
    unsigned char* ws = a.ws;
    bf16_t* XB = (bf16_t*)(ws + WS_XB);
    bf16_t* BR = (bf16_t*)(ws + WS_BR);
    bf16_t* Pb = (bf16_t*)(ws + WS_P);
    float* HRAW = (float*)(ws + WS_HRAW);
    LAS unsigned char* lds3 = (LAS unsigned char*)lds;

    for (int ph = a.ph_lo; ph < a.ph_hi; ++ph) {
        int tid = threadIdx.x; asm volatile("" : "+v"(tid));
        int bid = blockIdx.x; asm volatile("" : "+s"(bid));
        const int lane = tid & 63, wave = __builtin_amdgcn_readfirstlane(tid >> 6), gw = bid * 8 + wave;
        if (ph == 0) {
            convert_weights(a, 0, lds, gw, NGW, wave, lane);
            norm_phase(a.in[I_X], nullptr, nullptr, nullptr, 0.f, a.in[I_F1PRE], XB, gw, NGW, lane);
        } else {
            const int l = (ph - 1) / 11, s = (ph - 1) % 11;
            const float* xin = (l == 0 && s == 2) ? a.in[I_X] : a.out;
            switch (s) {
            case 0: case 8: {
                pg8::Gemm g{XB, (const bf16_t*)(ws + (s == 0 ? W_GU1 : W_GU2)), MTOK, INW, DM}; pg8::StaticOrder S; S.init(MTOK, INW, G, bid);
                pg8::EpiSwiglu E{Pb};
                pg8::gemm_phase<pg8::EpiSwiglu>(tid, lds3, g, S, E);
            } break;
            case 1: case 9: {
                pg8::Gemm g{Pb, (const bf16_t*)(ws + (s == 1 ? W_D1 : W_D2)), MTOK, DM, FF}; pg8::StaticOrder S; S.init(MTOK, DM, G, bid);
                pg8::EpiF32 E{HRAW};
                pg8::gemm_phase<pg8::EpiF32>(tid, lds3, g, S, E);
            } break;
            case 2:
                norm_phase(xin, a.out, HRAW, a.in[I_F1POST] + l * DM, 0.5f, a.in[I_MPRE] + l * DM, XB, gw, NGW, lane);
                break;
            case 3: {
                pg8::Gemm g{XB, (const bf16_t*)(ws + W_IN), MTOK, INW, DM}; pg8::StaticOrder S; S.init(MTOK, INW, G, bid);
                pg8::EpiMix E{Pb, a.in[I_BGATE] + l * 3 * DM};
                pg8::gemm_phase<pg8::EpiMix>(tid, lds3, g, S, E);
            } break;
            case 4:
                attn_phase(tid, bid, G, lds, Pb, BR);
                pool_phase(tid, bid, G, lds, Pb, BR, a.in[I_POOLW] + l * 4 * 4096, a.in[I_POOLS] + l * 256);
                conv_phase(tid, bid, G, Pb, BR, a.in[I_CONVW] + l * 3 * 256, a.in[I_CONVB] + l * 256);
                break;
            case 5: {
                pg8::Gemm g{BR, (const bf16_t*)(ws + W_BR), MTOK, DM, DM}; pg8::StaticOrder S; S.init(MTOK, DM, G, bid);
                pg8::EpiMerged E{XB, Pb + OFF_GATE};
                pg8::gemm_phase<pg8::EpiMerged>(tid, lds3, g, S, E);
            } break;
            case 6: {
                pg8::Gemm g{XB, (const bf16_t*)(ws + W_OUT), MTOK, DM, DM}; pg8::StaticOrder S; S.init(MTOK, DM, G, bid);
                pg8::EpiF32 E{HRAW};
                pg8::gemm_phase<pg8::EpiF32>(tid, lds3, g, S, E);
            } break;
            case 7:
                norm_phase(xin, a.out, HRAW, a.in[I_MPOST] + l * DM, 1.0f, a.in[I_F2PRE] + l * DM, XB, gw, NGW, lane);
                break;
            case 10:
                norm_phase(xin, a.out, HRAW, a.in[I_F2POST] + l * DM, 0.5f, (l + 1 < DEPTH) ? a.in[I_F1PRE] + (l + 1) * DM : nullptr, XB, gw, NGW, lane);
                if (l + 1 < DEPTH) { __syncthreads(); convert_weights(a, l + 1, lds, gw, NGW, wave, lane); }
                break;
            default: break;
            }
        }
        if (ph + 1 < a.ph_hi) { __syncthreads(); grid.sync(); }
    }
}

extern "C" void kernel_launch(void* const* d_in, const int* in_sizes, int n_in, void* d_out, int out_size, void* d_ws, size_t ws_size, hipStream_t stream) {
    static int grid_blocks = 0;
    if (grid_blocks == 0) {
        if (n_in != 23 || out_size != MTOK * DM || ws_size < WS_NEED) {
            fprintf(stderr, "kernel_launch: unexpected problem (n_in %d, out %d, ws %zu, need %zu)\n", n_in, out_size, ws_size, (size_t)WS_NEED);
            grid_blocks = -1; return;
        }
        int dev = 0, cus = 0, per_cu = 0;
        hipGetDevice(&dev);
        hipDeviceGetAttribute(&cus, hipDeviceAttributeMultiprocessorCount, dev);
        hipFuncSetAttribute((const void*)fwd_megakernel, hipFuncAttributeMaxDynamicSharedMemorySize, LDS_BYTES);
        if (hipOccupancyMaxActiveBlocksPerMultiprocessor(&per_cu, (const void*)fwd_megakernel, 512, LDS_BYTES) != hipSuccess || per_cu < 1) per_cu = 1;
        (void)hipGetLastError();
        if (per_cu > 1) per_cu = 1;
        grid_blocks = cus * per_cu;
    }
    if (grid_blocks < 0) return;
    Args a{};
    for (int i = 0; i < 23; ++i) a.in[i] = (const float*)d_in[i];
    a.out = (float*)d_out; a.ws = (unsigned char*)d_ws;
#if MULTI_LAUNCH
    for (int ph = 0; ph < NPHASE; ++ph) {
        a.ph_lo = ph; a.ph_hi = ph + 1;
        hipLaunchKernelGGL(fwd_megakernel, dim3(grid_blocks), dim3(512), LDS_BYTES, stream, a);
    }
#else
    a.ph_lo = 0; a.ph_hi = NPHASE;
    void* args[] = {&a};
    hipError_t e = hipLaunchCooperativeKernel((const void*)fwd_megakernel, dim3(grid_blocks), dim3(512), args, LDS_BYTES, stream);
    if (e != hipSuccess) fprintf(stderr, "cooperative launch failed: %s (grid %d)\n", hipGetErrorString(e), grid_blocks);
#endif
}
```

```cpp
#include <hip/hip_runtime.h>
#include <hip/hip_cooperative_groups.h>
#include <cstdio>
#include <cstdint>
namespace cg = cooperative_groups;

#ifndef PROBE_REP
#define PROBE_REP 0
#endif
#ifndef MULTI_LAUNCH
#define MULTI_LAUNCH 0
#endif

#define LAS __attribute__((address_space(3)))
typedef unsigned short bf16_t;
typedef short bf16x8 __attribute__((ext_vector_type(8)));
typedef float f32x4 __attribute__((ext_vector_type(4)));
typedef float f32x16 __attribute__((ext_vector_type(16)));
typedef unsigned u32x4 __attribute__((ext_vector_type(4)));
typedef unsigned u32x2 __attribute__((ext_vector_type(2)));

constexpr int DM = 1024, NBATCH = 32, SEQ = 2048, DEPTH = 4, MTOK = NBATCH * SEQ;
constexpr int FF = 2816, INW = 5632, NHEAD = 8, HD = 64;
constexpr int OFF_Q = 256, OFF_K = 768, OFF_V = 1280, OFF_CX = 1792, OFF_CB = 2048, OFF_CC = 2304, OFF_GATE = 2560;
constexpr float EPS = 1e-6f;
constexpr float LOG2E = 1.4426950408889634f, LN2 = 0.6931471805599453f;

constexpr size_t MiB = 1u << 20;
constexpr size_t W_GU1 = 0, W_D1 = W_GU1 + (size_t)INW * DM * 2, W_IN = W_D1 + (size_t)DM * FF * 2, W_BR = W_IN + (size_t)INW * DM * 2,
                 W_OUT = W_BR + (size_t)DM * DM * 2, W_GU2 = W_OUT + (size_t)DM * DM * 2, W_D2 = W_GU2 + (size_t)INW * DM * 2, W_END = W_D2 + (size_t)DM * FF * 2;
static_assert(W_END == 48 * MiB, "weights region");
constexpr size_t WS_XB = 48 * MiB;
constexpr size_t WS_BR = 176 * MiB;
constexpr size_t WS_P = 304 * MiB;
constexpr size_t WS_HRAW = WS_P + 352 * MiB;
constexpr size_t WS_NEED = WS_P + 704 * MiB;

__device__ __forceinline__ unsigned cvt_pk_bf16(float lo, float hi) { unsigned r; asm volatile("v_cvt_pk_bf16_f32 %0, %1, %2" : "=v"(r) : "v"(lo), "v"(hi)); return r; }
__device__ __forceinline__ float bf_lo(unsigned w) { return __uint_as_float(w << 16); }
__device__ __forceinline__ float bf_hi(unsigned w) { return __uint_as_float(w & 0xffff0000u); }
__device__ __forceinline__ float bf2f(bf16_t b) { return __uint_as_float((unsigned)b << 16); }
__device__ __forceinline__ float fast_sigmoid(float x) { return __builtin_amdgcn_rcpf(1.0f + __builtin_amdgcn_exp2f(-x * LOG2E)); }
__device__ __forceinline__ float wave_sum(float v) {
#pragma unroll
    for (int o = 1; o < 64; o <<= 1) v += __shfl_xor(v, o);
    return v;
}

namespace pg8 {
constexpr int BM = 256, BK = 64, HALF = 128, HTB = HALF * BK * 2, STAGE_BYTES = 8 * HTB, NXCD = 8, WGM = 8;
__host__ __device__ __forceinline__ int lds_byte(int r, int c) { const int st = (r >> 4) * 2 + (c >> 5), rr = r & 15, cc = c & 31, ob = rr * 64 + cc * 2; return st * 1024 + (ob ^ (((ob >> 9) & 1) << 5)); }
__host__ __device__ __forceinline__ void stage_rc(int b, int& R, int& C) { const int st = b / 1024, sb = b % 1024, swz = sb ^ (((sb >> 9) & 1) << 5); R = (st >> 1) * 16 + swz / 64; C = (st & 1) * 32 + (swz % 64) / 2; }
__host__ __device__ __forceinline__ int perm32(int rho) { const int n = rho >> 4, i = rho & 15; return 8 * (i >> 2) + 4 * n + (i & 3); }

struct Unit { int pm, pn; };
struct Gemm { const bf16_t* A; const bf16_t* Bt; int M, N, K; };

struct StaticOrder {
    int nM, nN, nwg, G, c;
    __device__ void init(int M, int N, int G_, int c_) { nM = M / BM; nN = N / BM; nwg = nM * nN; G = G_; c = c_; }
    __device__ bool next(int i, Unit& u) const {
        const long L = (long)i * G + c; if (L >= nwg) return false;
        int wgid = (int)L; { const int q = nwg / NXCD, r = nwg % NXCD, xcd = wgid % NXCD, off = wgid / NXCD; wgid = (xcd < r ? xcd * (q + 1) : r * (q + 1) + (xcd - r) * q) + off; }
        const int nig = WGM * nN, gid = wgid / nig, fm = gid * WGM, gsz = (nM - fm) < WGM ? (nM - fm) : WGM;
        u.pm = fm + ((wgid % nig) % gsz); u.pn = (wgid % nig) / gsz; return true;
    }
};

typedef f32x4 Acc[2][2][4][2];

struct EpiSwiglu {
    static constexpr bool PERM = true, HOOK = false;
    bf16_t* O;
    __device__ __forceinline__ void hook(Acc&, const Unit&, int, int, int, int, int) const {}
    __device__ __forceinline__ void operator()(Acc& acc, const Unit& u, int wr, int wc, int fr, int fq) const {
        const int row0 = u.pm * BM + wr * 64 + fr, col0 = u.pn * 128 + wc * 32 + 8 * fq;
#pragma unroll
        for (int ai = 0; ai < 2; ++ai)
#pragma unroll
            for (int m = 0; m < 4; ++m) {
                bf16_t* rowp = O + (size_t)(row0 + ai * HALF + m * 16) * FF + col0;
                float h[8];
#pragma unroll
                for (int n = 0; n < 2; ++n)
#pragma unroll
                    for (int j = 0; j < 4; ++j) { const float g = acc[ai][0][m][n][j], up = acc[ai][1][m][n][j]; h[n * 4 + j] = g * fast_sigmoid(g) * up; }
                u32x4 w; w.x = cvt_pk_bf16(h[0], h[1]); w.y = cvt_pk_bf16(h[2], h[3]); w.z = cvt_pk_bf16(h[4], h[5]); w.w = cvt_pk_bf16(h[6], h[7]);
                *(u32x4*)rowp = w;
            }
    }
};
struct EpiF32 {
    static constexpr bool PERM = false, HOOK = false;
    float* O;
    __device__ __forceinline__ void hook(Acc&, const Unit&, int, int, int, int, int) const {}
    __device__ __forceinline__ void operator()(Acc& acc, const Unit& u, int wr, int wc, int fr, int fq) const {
        const int row0 = u.pm * BM + wr * 64 + fr, col0 = u.pn * BM + wc * 32 + 4 * fq;
#pragma unroll
        for (int ai = 0; ai < 2; ++ai)
#pragma unroll
            for (int m = 0; m < 4; ++m) {
                float* rowp = O + (size_t)(row0 + ai * HALF + m * 16) * DM + col0;
#pragma unroll
                for (int bj = 0; bj < 2; ++bj)
#pragma unroll
                    for (int n = 0; n < 2; ++n) *(f32x4*)(rowp + bj * HALF + n * 16) = acc[ai][bj][m][n];
            }
    }
};
struct EpiMix {
    static constexpr bool PERM = true, HOOK = false;
    bf16_t* O; const float* bgate;
    __device__ __forceinline__ void hook(Acc&, const Unit&, int, int, int, int, int) const {}
    __device__ __forceinline__ void operator()(Acc& acc, const Unit& u, int wr, int wc, int fr, int fq) const {
        const int row0 = u.pm * BM + wr * 64 + fr, col0 = u.pn * BM + wc * 32 + 8 * fq;
        const bool gate = u.pn >= 10;
        f32x4 bv[2][2];
#pragma unroll
        for (int bj = 0; bj < 2; ++bj)
#pragma unroll
            for (int n = 0; n < 2; ++n) bv[bj][n] = gate ? *(const f32x4*)(bgate + (col0 - OFF_GATE) + bj * HALF + 4 * n) : (f32x4){0.f, 0.f, 0.f, 0.f};
#pragma unroll
        for (int ai = 0; ai < 2; ++ai)
#pragma unroll
            for (int m = 0; m < 4; ++m) {
                bf16_t* rowp = O + (size_t)(row0 + ai * HALF + m * 16) * INW + col0;
#pragma unroll
                for (int bj = 0; bj < 2; ++bj) {
                    f32x4 v0 = acc[ai][bj][m][0], v1 = acc[ai][bj][m][1];
                    if (gate) {
                        v0 = v0 + bv[bj][0]; v1 = v1 + bv[bj][1];
#pragma unroll
                        for (int j = 0; j < 4; ++j) { v0[j] = fast_sigmoid(v0[j]); v1[j] = fast_sigmoid(v1[j]); }
                    }
                    u32x4 w; w.x = cvt_pk_bf16(v0[0], v0[1]); w.y = cvt_pk_bf16(v0[2], v0[3]); w.z = cvt_pk_bf16(v1[0], v1[1]); w.w = cvt_pk_bf16(v1[2], v1[3]);
                    *(u32x4*)(rowp + bj * HALF) = w;
                }
            }
    }
};
struct EpiMerged {
    static constexpr bool PERM = true, HOOK = true;
    bf16_t* O; const bf16_t* G;
    __device__ __forceinline__ void hook(Acc& acc, const Unit& u, int wr, int wc, int fr, int fq, int which) const {
        int row0 = u.pm * BM + wr * 64 + fr, col0 = u.pn * BM + wc * 32 + 8 * fq;
        asm volatile("" : "+v"(row0), "+v"(col0));
#pragma unroll
        for (int ai = 0; ai < 2; ++ai)
#pragma unroll
            for (int m = 0; m < 4; ++m) {
                const bf16_t* gp = G + (size_t)(row0 + ai * HALF + m * 16) * INW + which * DM + col0;
#pragma unroll
                for (int bj = 0; bj < 2; ++bj) {
                    const u32x4 a = *(const u32x4*)(gp + bj * HALF), b = *(const u32x4*)(gp + DM + bj * HALF);
                    float r[8];
#pragma unroll
                    for (int j = 0; j < 4; ++j) {
                        r[2 * j] = bf_lo(a[j]) * __builtin_amdgcn_rcpf(fmaxf(bf_lo(b[j]), 1e-30f));
                        r[2 * j + 1] = bf_hi(a[j]) * __builtin_amdgcn_rcpf(fmaxf(bf_hi(b[j]), 1e-30f));
                    }
#pragma unroll
                    for (int j = 0; j < 4; ++j) { acc[ai][bj][m][0][j] *= r[j]; acc[ai][bj][m][1][j] *= r[4 + j]; }
                }
                asm volatile("" ::: "memory");
            }
    }
    __device__ __forceinline__ void operator()(Acc& acc, const Unit& u, int wr, int wc, int fr, int fq) const {
        const int row0 = u.pm * BM + wr * 64 + fr, col0 = u.pn * BM + wc * 32 + 8 * fq;
#pragma unroll
        for (int ai = 0; ai < 2; ++ai)
#pragma unroll
            for (int m = 0; m < 4; ++m) {
                const size_t row = (size_t)(row0 + ai * HALF + m * 16);
                const bf16_t* gp = G + row * INW + 2 * DM + col0;
                bf16_t* rowp = O + row * DM + col0;
#pragma unroll
                for (int bj = 0; bj < 2; ++bj) {
                    const u32x4 a = *(const u32x4*)(gp + bj * HALF);
                    const f32x4 v0 = acc[ai][bj][m][0], v1 = acc[ai][bj][m][1];
                    u32x4 w;
                    w.x = cvt_pk_bf16(v0[0] * bf_lo(a[0]), v0[1] * bf_hi(a[0])); w.y = cvt_pk_bf16(v0[2] * bf_lo(a[1]), v0[3] * bf_hi(a[1]));
                    w.z = cvt_pk_bf16(v1[0] * bf_lo(a[2]), v1[1] * bf_hi(a[2])); w.w = cvt_pk_bf16(v1[2] * bf_lo(a[3]), v1[3] * bf_hi(a[3]));
                    *(u32x4*)(rowp + bj * HALF) = w;
                }
                asm volatile("" ::: "memory");
            }
    }
};

template <class Epi>
__device__ __forceinline__ void gemm_phase(const int tid, LAS unsigned char* lds, const Gemm g, const StaticOrder& S, const Epi& E) {
    const int wid = __builtin_amdgcn_readfirstlane(tid >> 6), lane = tid & 63, wr = wid >> 2, wc = wid & 3, fr = lane & 15, fq = lane >> 4;
    const int K = g.K, nt = K / BK;
    unsigned voffA[2], voffB[2];
#pragma unroll
    for (int i = 0; i < 2; ++i) { int R, C; stage_rc(tid * 16 + i * 8192, R, C); const int Rb = Epi::PERM ? ((R & ~31) + perm32(R & 31)) : R;
        voffA[i] = (unsigned)(R * K + C) * 2u; voffB[i] = (unsigned)(Rb * K + C) * 2u; }
    const size_t kstep = (size_t)(BK * 2);
    const size_t hstep = (size_t)HALF * K * 2;
    const size_t tstep = 2 * hstep;
    const unsigned ldsw = (unsigned)wid * 1024u;
    const int aoff = lds_byte(wr * 64 + fr, fq * 8), boff = lds_byte(wc * 32 + fr, fq * 8);
#define PG8_SA(b, h) (((b) * 2 + (h)) * HTB)
#define PG8_SB(b, h) ((4 + (b) * 2 + (h)) * HTB)
#define PG8_STAGE(bufoff, gbase, voff) do { _Pragma("unroll") for (int _i = 0; _i < 2; ++_i) \
        __builtin_amdgcn_global_load_lds((const unsigned*)((const char*)(gbase) + (voff)[_i]), (LAS unsigned*)(lds + (bufoff) + ldsw + _i * 8192), 16, 0, 0); } while (0)
#define PG8_LDA(dst, b, h) do { _Pragma("unroll") for (int m = 0; m < 4; ++m) _Pragma("unroll") for (int k = 0; k < 2; ++k) dst[m][k] = *(const LAS bf16x8*)(lds + PG8_SA(b, h) + aoff + m * 2048 + k * 1024); } while (0)
#define PG8_LDB(dst, b, h) do { _Pragma("unroll") for (int n = 0; n < 2; ++n) _Pragma("unroll") for (int k = 0; k < 2; ++k) dst[n][k] = *(const LAS bf16x8*)(lds + PG8_SB(b, h) + boff + n * 2048 + k * 1024); } while (0)
#define PG8_MMA(ai, bj, At, Bt) do { __builtin_amdgcn_s_setprio(1); _Pragma("unroll") for (int m = 0; m < 4; ++m) _Pragma("unroll") for (int n = 0; n < 2; ++n) _Pragma("unroll") for (int k = 0; k < 2; ++k) \
        acc[ai][bj][m][n] = __builtin_amdgcn_mfma_f32_16x16x32_bf16(Bt[n][k], At[m][k], acc[ai][bj][m][n], 0, 0, 0); __builtin_amdgcn_s_setprio(0); } while (0)
#define PG8_WAIT_V(n) asm volatile("s_waitcnt vmcnt(" #n ")" ::: "memory")
#define PG8_WAIT_L(n) asm volatile("s_waitcnt lgkmcnt(" #n ")" ::: "memory")
#define PG8_BAR __builtin_amdgcn_s_barrier()
#define PG8_SCHED __builtin_amdgcn_sched_barrier(0)
    Unit cur, nxt; int ui = 0;
    if (!S.next(0, cur)) return;
    Acc acc;
#pragma unroll
    for (int a = 0; a < 2; ++a)
#pragma unroll
        for (int b = 0; b < 2; ++b)
#pragma unroll
            for (int m = 0; m < 4; ++m)
#pragma unroll
                for (int n = 0; n < 2; ++n) acc[a][b][m][n] = (f32x4){0.f, 0.f, 0.f, 0.f};
    bf16x8 At[4][2], B0[2][2], B1[2][2];
    const char* cA = (const char*)g.A + (size_t)cur.pm * tstep; const char* cB = (const char*)g.Bt + (size_t)cur.pn * tstep;
    PG8_STAGE(PG8_SB(0, 0), cB, voffB); PG8_STAGE(PG8_SB(0, 1), cB + hstep, voffB); PG8_STAGE(PG8_SA(0, 0), cA, voffA); PG8_STAGE(PG8_SA(0, 1), cA + hstep, voffA);
    if (wr == 1) PG8_BAR;
    PG8_WAIT_V(2); PG8_BAR;
    PG8_STAGE(PG8_SB(1, 0), cB + kstep, voffB); PG8_STAGE(PG8_SA(1, 0), cA + kstep, voffA); PG8_STAGE(PG8_SB(1, 1), cB + hstep + kstep, voffB);
    PG8_WAIT_V(6); PG8_BAR;
    for (;;) {
        const bool has_next = S.next(ui + 1, nxt);
        const char* nA = has_next ? (const char*)g.A + (size_t)nxt.pm * tstep : cA; const char* nB = has_next ? (const char*)g.Bt + (size_t)nxt.pn * tstep : cB;
        for (int t = 0; t < nt; t += 2) {
            const bool last = (t == nt - 2);
            const char* a1 = cA + (size_t)(t + 1) * kstep;
            const char* a2 = last ? nA : cA + (size_t)(t + 2) * kstep; const char* b2 = last ? nB : cB + (size_t)(t + 2) * kstep;
            const char* a3 = a2 + kstep; const char* b3 = b2 + kstep;
            PG8_LDB(B0, 0, 0); PG8_LDB(B1, 0, 1); PG8_SCHED; PG8_LDA(At, 0, 0); PG8_STAGE(PG8_SA(1, 1), a1 + hstep, voffA);
            PG8_WAIT_V(8); PG8_WAIT_L(0); PG8_BAR; PG8_MMA(0, 0, At, B0); PG8_MMA(0, 1, At, B1); PG8_BAR; PG8_SCHED;
            PG8_LDA(At, 0, 1); PG8_STAGE(PG8_SB(0, 0), b2, voffB); PG8_STAGE(PG8_SB(0, 1), b2 + hstep, voffB); PG8_STAGE(PG8_SA(0, 0), a2, voffA);
            PG8_WAIT_V(8); PG8_WAIT_L(0); PG8_BAR; PG8_MMA(1, 0, At, B0); PG8_MMA(1, 1, At, B1); PG8_BAR; PG8_SCHED;
            PG8_LDB(B0, 1, 0); PG8_LDB(B1, 1, 1); PG8_SCHED; PG8_LDA(At, 1, 0); PG8_STAGE(PG8_SA(0, 1), a2 + hstep, voffA);
            PG8_WAIT_V(8); PG8_WAIT_L(0); PG8_BAR; PG8_MMA(0, 0, At, B0); PG8_MMA(0, 1, At, B1); PG8_BAR; PG8_SCHED;
            PG8_LDA(At, 1, 1); PG8_STAGE(PG8_SB(1, 0), b3, voffB); PG8_STAGE(PG8_SB(1, 1), b3 + hstep, voffB); PG8_STAGE(PG8_SA(1, 0), a3, voffA);
            PG8_WAIT_V(8); PG8_WAIT_L(0); PG8_BAR; PG8_MMA(1, 0, At, B0); PG8_MMA(1, 1, At, B1); PG8_BAR; PG8_SCHED;
            if constexpr (Epi::HOOK) { if (t == 2 || t == 10) E.hook(acc, cur, wr, wc, fr, fq, t == 10 ? 1 : 0); PG8_SCHED; }
        }
        if (wr == 0) PG8_BAR;
        E(acc, cur, wr, wc, fr, fq);
        if (!has_next) break;
#pragma unroll
        for (int a = 0; a < 2; ++a)
#pragma unroll
            for (int b = 0; b < 2; ++b)
#pragma unroll
                for (int m = 0; m < 4; ++m)
#pragma unroll
                    for (int n = 0; n < 2; ++n) acc[a][b][m][n] = (f32x4){0.f, 0.f, 0.f, 0.f};
        cur = nxt; cA = nA; cB = nB; ++ui;
        if (wr == 1) PG8_BAR;
    }
    PG8_WAIT_V(0);
    PG8_BAR;
#undef PG8_SA
#undef PG8_SB
#undef PG8_STAGE
#undef PG8_LDA
#undef PG8_LDB
#undef PG8_MMA
#undef PG8_WAIT_V
#undef PG8_WAIT_L
#undef PG8_BAR
#undef PG8_SCHED
}
}

struct Args {
    const float* in[23];
    float* out;
    unsigned char* ws;
    int ph_lo, ph_hi;
};
enum { I_X = 0, I_F1PRE, I_F1POST, I_F1WG, I_F1WU, I_F1WD, I_MPRE, I_MPOST, I_WIN, I_BGATE, I_POOLW, I_POOLS, I_CONVW, I_CONVB,
       I_WBP, I_WBS, I_WBC, I_WOUT, I_F2PRE, I_F2POST, I_F2WG, I_F2WU, I_F2WD };

__device__ __forceinline__ void transpose_item(const float* W, int N, int k0, int n0, bf16_t* WT, int dpitch, int drow0, int dk0, float scale, float* scr, int lane) {
#pragma unroll 8
    for (int i = 0; i < 32; ++i) { const int kk = 2 * i + (lane >> 5); scr[kk * 33 + (lane & 31)] = W[(size_t)(k0 + kk) * N + n0 + (lane & 31)]; }
    asm volatile("s_waitcnt lgkmcnt(0)" ::: "memory");
    const int c = lane & 7;
#pragma unroll
    for (int j = 0; j < 4; ++j) { const int n = (lane >> 3) + 8 * j; const float* s = scr + (8 * c) * 33 + n;
        u32x4 o; o.x = cvt_pk_bf16(s[0 * 33] * scale, s[1 * 33] * scale); o.y = cvt_pk_bf16(s[2 * 33] * scale, s[3 * 33] * scale);
        o.z = cvt_pk_bf16(s[4 * 33] * scale, s[5 * 33] * scale); o.w = cvt_pk_bf16(s[6 * 33] * scale, s[7 * 33] * scale);
        *(u32x4*)(WT + (size_t)(drow0 + n) * dpitch + dk0 + 8 * c) = o; }
    asm volatile("s_waitcnt lgkmcnt(0)" ::: "memory");
}
__device__ __forceinline__ bool convert_matrix(int& r, const float* W, int K, int N, bf16_t* WT, int dpitch, int dk_off, int kind, float* scr, int lane) {
    const int nblk = N / 32, items = (K / 64) * nblk;
    if (r >= items) { r -= items; return false; }
    const int kb = r / nblk, nb = r % nblk, k0 = 64 * kb, n0 = 32 * nb;
    int drow0 = n0; float scale = 1.0f;
    if (kind == 1) drow0 = 256 * (n0 >> 7) + (n0 & 127);
    else if (kind == 2) drow0 = 256 * (n0 >> 7) + 128 + (n0 & 127);
    else if (kind == 3) scale = (n0 >= OFF_Q && n0 < OFF_K) ? 0.125f : 1.0f;
    transpose_item(W, N, k0, n0, WT, dpitch, drow0, dk_off + k0, scale, scr, lane);
    return true;
}
__device__ __forceinline__ void convert_weights(const Args& a, int l, unsigned char* ldsraw, int gw, int NGW, int wave, int lane) {
    float* scr = (float*)(ldsraw + wave * 16384);
    unsigned char* ws = a.ws;
    constexpr int NITEMS = 12288;
    const size_t gu = (size_t)l * DM * FF, dn = (size_t)l * FF * DM;
    for (int it = gw; it < NITEMS; it += NGW) {
        int r = it;
        if (convert_matrix(r, a.in[I_F1WG] + gu, DM, FF, (bf16_t*)(ws + W_GU1), DM, 0, 1, scr, lane)) continue;
        if (convert_matrix(r, a.in[I_F1WU] + gu, DM, FF, (bf16_t*)(ws + W_GU1), DM, 0, 2, scr, lane)) continue;
        if (convert_matrix(r, a.in[I_F1WD] + dn, FF, DM, (bf16_t*)(ws + W_D1), FF, 0, 0, scr, lane)) continue;
        if (convert_matrix(r, a.in[I_WIN] + (size_t)l * DM * INW, DM, INW, (bf16_t*)(ws + W_IN), DM, 0, 3, scr, lane)) continue;
        if (convert_matrix(r, a.in[I_WBP] + (size_t)l * 256 * DM, 256, DM, (bf16_t*)(ws + W_BR), DM, 0, 0, scr, lane)) continue;
        if (convert_matrix(r, a.in[I_WBS] + (size_t)l * 512 * DM, 512, DM, (bf16_t*)(ws + W_BR), DM, 256, 0, scr, lane)) continue;
        if (convert_matrix(r, a.in[I_WBC] + (size_t)l * 256 * DM, 256, DM, (bf16_t*)(ws + W_BR), DM, 768, 0, scr, lane)) continue;
        if (convert_matrix(r, a.in[I_WOUT] + (size_t)l * DM * DM, DM, DM, (bf16_t*)(ws + W_OUT), DM, 0, 0, scr, lane)) continue;
        if (convert_matrix(r, a.in[I_F2WG] + gu, DM, FF, (bf16_t*)(ws + W_GU2), DM, 0, 1, scr, lane)) continue;
        if (convert_matrix(r, a.in[I_F2WU] + gu, DM, FF, (bf16_t*)(ws + W_GU2), DM, 0, 2, scr, lane)) continue;
        convert_matrix(r, a.in[I_F2WD] + dn, FF, DM, (bf16_t*)(ws + W_D2), FF, 0, 0, scr, lane);
    }
}

__device__ __forceinline__ void norm_phase(const float* xin, float* xout, const float* h, const float* gpost, float c, const float* gpre, bf16_t* XB, int gw, int NGW, int lane) {
    f32x4 gp[4], gq[4];
#pragma unroll
    for (int j = 0; j < 4; ++j) { gp[j] = h ? ((const f32x4*)gpost)[lane + 64 * j] : (f32x4){0.f, 0.f, 0.f, 0.f}; gq[j] = gpre ? ((const f32x4*)gpre)[lane + 64 * j] : (f32x4){0.f, 0.f, 0.f, 0.f}; }
    for (int row = gw; row < MTOK; row += NGW) {
        const f32x4* xr = (const f32x4*)(xin + (size_t)row * DM) + lane;
        f32x4 x[4];
#pragma unroll
        for (int j = 0; j < 4; ++j) x[j] = xr[64 * j];
        if (h) {
            const f32x4* hr = (const f32x4*)(h + (size_t)row * DM) + lane;
            f32x4 hv[4]; float ss = 0.f;
#pragma unroll
            for (int j = 0; j < 4; ++j) { hv[j] = hr[64 * j]; ss += (hv[j].x * hv[j].x + hv[j].y * hv[j].y) + (hv[j].z * hv[j].z + hv[j].w * hv[j].w); }
            const float rinv = c * __builtin_amdgcn_rsqf(wave_sum(ss) * (1.0f / DM) + EPS);
            f32x4* orow = (f32x4*)(xout + (size_t)row * DM) + lane;
#pragma unroll
            for (int j = 0; j < 4; ++j) { x[j] = x[j] + hv[j] * gp[j] * rinv; orow[64 * j] = x[j]; }
        }
        if (gpre) {
            float s2 = 0.f;
#pragma unroll
            for (int j = 0; j < 4; ++j) s2 += (x[j].x * x[j].x + x[j].y * x[j].y) + (x[j].z * x[j].z + x[j].w * x[j].w);
            const float r2 = __builtin_amdgcn_rsqf(wave_sum(s2) * (1.0f / DM) + EPS);
            u32x2* o8 = (u32x2*)(XB + (size_t)row * DM) + lane;
#pragma unroll
            for (int j = 0; j < 4; ++j) { const f32x4 v = x[j] * gq[j] * r2; u32x2 w; w.x = cvt_pk_bf16(v.x, v.y); w.y = cvt_pk_bf16(v.z, v.w); o8[64 * j] = w; }
        }
    }
}

constexpr int KP = 72;
constexpr int ATT_TILE = 64 * KP;
constexpr float ATT_SKIP = 120.0f;
__device__ __forceinline__ int crow(int i, int hi) { return (i & 3) + 8 * (i >> 2) + 4 * hi; }

__device__ __forceinline__ void attn_sub(const f32x16& z, int kbase  , int tq, bool needmask, int hi, float carry_in, float& tot_out, bf16x8& p0, bf16x8& p1) {
    float sp[16];
#pragma unroll
    for (int i = 0; i < 16; ++i) {
        const float zi = z[i];
        const float e = __builtin_amdgcn_exp2f(-fabsf(zi) * LOG2E);
        float s = fmaxf(zi, 0.f) + __builtin_amdgcn_logf(1.0f + e) * LN2;
        if (needmask && (kbase + crow(i, hi) >= tq)) s = 0.f;
        sp[i] = s;
    }
    float G[4], Gp[4];
#pragma unroll
    for (int k = 0; k < 4; ++k) { G[k] = (sp[4 * k] + sp[4 * k + 1]) + (sp[4 * k + 2] + sp[4 * k + 3]); Gp[k] = __shfl_xor(G[k], 32); }
    float run = carry_in;
    float A[16];
#pragma unroll
    for (int k = 3; k >= 0; --k) {
        const float base = run + (hi == 0 ? Gp[k] : 0.f);
        const float c3 = base + sp[4 * k + 3], c2 = c3 + sp[4 * k + 2], c1 = c2 + sp[4 * k + 1], c0 = c1 + sp[4 * k];
        A[4 * k + 3] = __builtin_amdgcn_exp2f((z[4 * k + 3] - c3) * LOG2E);
        A[4 * k + 2] = __builtin_amdgcn_exp2f((z[4 * k + 2] - c2) * LOG2E);
        A[4 * k + 1] = __builtin_amdgcn_exp2f((z[4 * k + 1] - c1) * LOG2E);
        A[4 * k + 0] = __builtin_amdgcn_exp2f((z[4 * k + 0] - c0) * LOG2E);
        run += G[k] + Gp[k];
    }
    if (needmask) {
#pragma unroll
        for (int i = 0; i < 16; ++i) if (kbase + crow(i, hi) >= tq) A[i] = 0.f;
    }
    tot_out = run - carry_in;
    u32x4 w0, w1;
    w0.x = cvt_pk_bf16(A[0], A[1]); w0.y = cvt_pk_bf16(A[2], A[3]); w0.z = cvt_pk_bf16(A[4], A[5]); w0.w = cvt_pk_bf16(A[6], A[7]);
    w1.x = cvt_pk_bf16(A[8], A[9]); w1.y = cvt_pk_bf16(A[10], A[11]); w1.z = cvt_pk_bf16(A[12], A[13]); w1.w = cvt_pk_bf16(A[14], A[15]);
    p0 = __builtin_bit_cast(bf16x8, w0); p1 = __builtin_bit_cast(bf16x8, w1);
}

__device__ __forceinline__ void attn_phase(const int tid, const int bid, const int G, unsigned char* ldsraw, const bf16_t* P, bf16_t* BR) {
    const int lane = tid & 63, r32 = lane & 31, hi = lane >> 5;
    const int wid = __builtin_amdgcn_readfirstlane(tid >> 6);
    bf16_t* Kl = (bf16_t*)ldsraw;
    bf16_t* Vl = (bf16_t*)ldsraw + 2 * ATT_TILE;
    volatile int* aflag = (volatile int*)(ldsraw + 4 * ATT_TILE * 2);
    const int skey = tid >> 3, sch = tid & 7;
    for (int u = bid; u < NBATCH * NHEAD * 8; u += G) {
        const int bh = u & 255, qb = u >> 8, b = bh >> 3, h = bh & 7;
        const size_t rowbase = (size_t)b * SEQ;
        const int q0 = qb * 256, NT = 4 * (qb + 1);
        const int tq = q0 + wid * 32 + r32;
        bf16x8 qf[4];
        { const bf16_t* Qw = P + (rowbase + tq) * INW + OFF_Q + h * HD + hi * 8;
#pragma unroll
          for (int d0 = 0; d0 < 4; ++d0) qf[d0] = *(const bf16x8*)(Qw + d0 * 16); }
        f32x16 o0 = {}, o1 = {};
        float R = 0.f;
        int alive = 1;
        const bf16_t* Kg = P + (rowbase + skey) * INW + OFF_K + h * HD + sch * 8;
        const bf16_t* Vg = P + (rowbase + skey) * INW + OFF_V + h * HD + sch * 8;
        u32x4 kreg = *(const u32x4*)(Kg + (size_t)(NT - 1) * 64 * INW), vreg = *(const u32x4*)(Vg + (size_t)(NT - 1) * 64 * INW);
        for (int it = 0; it < NT; ++it) {
            const int kb = NT - 1 - it, buf = it & 1;
            bf16_t* Kb = Kl + buf * ATT_TILE; bf16_t* Vb = Vl + buf * ATT_TILE;
            *(u32x4*)(Kb + skey * KP + sch * 8) = kreg;
#pragma unroll
            for (int e = 0; e < 4; ++e) { Vb[(sch * 8 + 2 * e) * KP + skey] = (bf16_t)(vreg[e] & 0xffffu); Vb[(sch * 8 + 2 * e + 1) * KP + skey] = (bf16_t)(vreg[e] >> 16); }
            if (it == 0) { if (tid == 0) { aflag[1] = 0; aflag[2] = 0; } __syncthreads(); }
            else {
                const int fi = it % 3;
                if (lane == 0 && alive) aflag[fi] = 1;
                __syncthreads();
                const int any_alive = aflag[fi];
                if (tid == 0) aflag[(it + 2) % 3] = 0;
                if (!any_alive) break;
            }
            if (it + 1 < NT) { kreg = *(const u32x4*)(Kg + (size_t)(kb - 1) * 64 * INW); vreg = *(const u32x4*)(Vg + (size_t)(kb - 1) * 64 * INW); }
            if (alive && kb * 64 <= q0 + wid * 32 + 30) {
                const bool needmask = (kb * 64 + 63 >= q0 + wid * 32);
                f32x16 z0 = {}, z1 = {};
#pragma unroll
                for (int d0 = 0; d0 < 4; ++d0) {
                    const bf16x8 k0 = *(const bf16x8*)(Kb + r32 * KP + d0 * 16 + hi * 8);
                    const bf16x8 k1 = *(const bf16x8*)(Kb + (32 + r32) * KP + d0 * 16 + hi * 8);
                    z0 = __builtin_amdgcn_mfma_f32_32x32x16_bf16(k0, qf[d0], z0, 0, 0, 0);
                    z1 = __builtin_amdgcn_mfma_f32_32x32x16_bf16(k1, qf[d0], z1, 0, 0, 0);
                }
                bf16x8 pf[4]; float t1, t0;
                attn_sub(z1, kb * 64 + 32, tq, needmask, hi, R, t1, pf[2], pf[3]);
                attn_sub(z0, kb * 64, tq, needmask, hi, R + t1, t0, pf[0], pf[1]);
                R += t1 + t0;
                alive = __any(!(R > ATT_SKIP)) ? 1 : 0;
#pragma unroll
                for (int s = 0; s < 4; ++s) {
                    const bf16_t* v0p = Vb + r32 * KP + 16 * s + 4 * hi;
                    const bf16_t* v1p = Vb + (32 + r32) * KP + 16 * s + 4 * hi;
                    const u32x2 a0 = *(const u32x2*)v0p, a1 = *(const u32x2*)(v0p + 8);
                    const u32x2 c0 = *(const u32x2*)v1p, c1 = *(const u32x2*)(v1p + 8);
                    const u32x4 va = {a0.x, a0.y, a1.x, a1.y}, vc = {c0.x, c0.y, c1.x, c1.y};
                    o0 = __builtin_amdgcn_mfma_f32_32x32x16_bf16(__builtin_bit_cast(bf16x8, va), pf[s], o0, 0, 0, 0);
                    o1 = __builtin_amdgcn_mfma_f32_32x32x16_bf16(__builtin_bit_cast(bf16x8, vc), pf[s], o1, 0, 0, 0);
                }
            }
        }
        bf16_t* Ow = BR + (rowbase + tq) * DM + 256 + h * HD + 4 * hi;
#pragma unroll
        for (int g = 0; g < 4; ++g) {
            u32x2 w; w.x = cvt_pk_bf16(o0[4 * g], o0[4 * g + 1]); w.y = cvt_pk_bf16(o0[4 * g + 2], o0[4 * g + 3]); *(u32x2*)(Ow + 8 * g) = w;
            u32x2 x; x.x = cvt_pk_bf16(o1[4 * g], o1[4 * g + 1]); x.y = cvt_pk_bf16(o1[4 * g + 2], o1[4 * g + 3]); *(u32x2*)(Ow + 32 + 8 * g) = x;
        }
        __syncthreads();
    }
}

__device__ __forceinline__ void pool_phase(const int tid, const int bid, const int G, unsigned char* ldsraw, const bf16_t* P, bf16_t* BR, const float* pool_w, const float* pool_scale) {
    float* U = (float*)ldsraw;
    float* Pl = U + 80 * 64;
    float* Wl = Pl + 64 * 65;
    for (int tile = bid; tile < (MTOK / 64) * 4; tile += G) {
        const int g = tile & 3, tt = tile >> 2, tok0 = tt * 64, t0 = tok0 & (SEQ - 1), w = 2 << g;
        for (int idx = tid; idx < 80 * 64; idx += 512) {
            const int r = idx >> 6, c = idx & 63, pos = t0 - 16 + r;
            U[idx] = pos >= 0 ? bf2f(P[(size_t)(tok0 - 16 + r) * INW + g * 64 + c]) : 0.f;
        }
        for (int idx = tid; idx < 64 * 64; idx += 512) Wl[idx] = pool_w[g * 4096 + idx];
        __syncthreads();
        for (int idx = tid; idx < 64 * 64; idx += 512) {
            const int t = idx >> 6, c = idx & 63;
            float s = 0.f;
            for (int j = 0; j < w; ++j) s += U[(16 + t - j) * 64 + c];
            const int cnt = (t0 + t + 1) < w ? (t0 + t + 1) : w;
            Pl[t * 65 + c] = s / (float)cnt - U[(16 + t) * 64 + c];
        }
        __syncthreads();
        {
            const int d = tid & 63, tq = tid >> 6;
            float acc[8];
#pragma unroll
            for (int i = 0; i < 8; ++i) acc[i] = 0.f;
            for (int c = 0; c < 64; ++c) {
                const float wv = Wl[c * 64 + d];
#pragma unroll
                for (int i = 0; i < 8; ++i) acc[i] += Pl[(8 * tq + i) * 65 + c] * wv;
            }
            const float sc = pool_scale[g * 64 + d];
#pragma unroll
            for (int i = 0; i < 8; ++i) BR[(size_t)(tok0 + 8 * tq + i) * DM + g * 64 + d] = (bf16_t)(cvt_pk_bf16(acc[i] * sc, 0.f) & 0xffffu);
        }
        __syncthreads();
    }
}

__device__ __forceinline__ void conv_phase(const int tid, const int bid, const int G, const bf16_t* P, bf16_t* BR, const float* conv_w, const float* conv_b) {
    for (int idx = bid * 512 + tid; idx < MTOK * 32; idx += G * 512) {
        const int row = idx >> 5, ch = (idx & 31) * 8, pos = row & (SEQ - 1);
        const bf16_t* pr = P + (size_t)row * INW;
        const u32x4 z = {0u, 0u, 0u, 0u};
        const u32x4 x0 = *(const u32x4*)(pr + OFF_CX + ch), c0 = *(const u32x4*)(pr + OFF_CC + ch), gb = *(const u32x4*)(pr + OFF_CB + ch);
        const u32x4 x1 = pos >= 1 ? *(const u32x4*)(pr - INW + OFF_CX + ch) : z, c1 = pos >= 1 ? *(const u32x4*)(pr - INW + OFF_CC + ch) : z;
        const u32x4 x2 = pos >= 2 ? *(const u32x4*)(pr - 2 * INW + OFF_CX + ch) : z, c2 = pos >= 2 ? *(const u32x4*)(pr - 2 * INW + OFF_CC + ch) : z;
        float y[8];
#pragma unroll
        for (int j = 0; j < 4; ++j) {
#pragma unroll
            for (int hh = 0; hh < 2; ++hh) {
                const int e = 2 * j + hh;
                const float u0 = hh ? bf_hi(x0[j]) * bf_hi(c0[j]) : bf_lo(x0[j]) * bf_lo(c0[j]);
                const float u1 = hh ? bf_hi(x1[j]) * bf_hi(c1[j]) : bf_lo(x1[j]) * bf_lo(c1[j]);
                const float u2 = hh ? bf_hi(x2[j]) * bf_hi(c2[j]) : bf_lo(x2[j]) * bf_lo(c2[j]);
                const float v = conv_b[ch + e] + conv_w[ch + e] * u2 + conv_w[256 + ch + e] * u1 + conv_w[512 + ch + e] * u0;
                y[e] = (hh ? bf_hi(gb[j]) : bf_lo(gb[j])) * v;
            }
        }
        u32x4 w; w.x = cvt_pk_bf16(y[0], y[1]); w.y = cvt_pk_bf16(y[2], y[3]); w.z = cvt_pk_bf16(y[4], y[5]); w.w = cvt_pk_bf16(y[6], y[7]);
        *(u32x4*)(BR + (size_t)row * DM + 768 + ch) = w;
    }
}

constexpr int LDS_BYTES = 131072 + 1024;
constexpr int NPHASE = 1 + 11 * DEPTH;

__global__ void __launch_bounds__(512, 2) fwd_megakernel(Args a) {
    extern __shared__ __attribute__((aligned(16))) unsigned char lds[];
    cg::grid_group grid = cg::this_grid();
    const int G = gridDim.x, NGW = G * 8;
    unsigned char* ws = a.ws;
    bf16_t* XB = (bf16_t*)(ws + WS_XB);
    bf16_t* BR = (bf16_t*)(ws + WS_BR);
    bf16_t* Pb = (bf16_t*)(ws + WS_P);
    float* HRAW = (float*)(ws + WS_HRAW);
    LAS unsigned char* lds3 = (LAS unsigned char*)lds;

    int rep = 0;
    for (int ph = a.ph_lo; ph < a.ph_hi;) {
        int tid = threadIdx.x; asm volatile("" : "+v"(tid));
        int bid = blockIdx.x; asm volatile("" : "+s"(bid));
        const int lane = tid & 63, wave = __builtin_amdgcn_readfirstlane(tid >> 6), gw = bid * 8 + wave;
        if (ph == 0) {
            convert_weights(a, 0, lds, gw, NGW, wave, lane);
            norm_phase(a.in[I_X], nullptr, nullptr, nullptr, 0.f, a.in[I_F1PRE], XB, gw, NGW, lane);
        } else {
            const int l = (ph - 1) / 11, s = (ph - 1) % 11;
            const float* xin = (l == 0 && s == 2) ? a.in[I_X] : a.out;
            switch (s) {
            case 0: case 8: {
                pg8::Gemm g{XB, (const bf16_t*)(ws + (s == 0 ? W_GU1 : W_GU2)), MTOK, INW, DM}; pg8::StaticOrder S; S.init(MTOK, INW, G, bid);
                pg8::EpiSwiglu E{Pb};
                pg8::gemm_phase<pg8::EpiSwiglu>(tid, lds3, g, S, E);
            } break;
            case 1: case 9: {
                pg8::Gemm g{Pb, (const bf16_t*)(ws + (s == 1 ? W_D1 : W_D2)), MTOK, DM, FF}; pg8::StaticOrder S; S.init(MTOK, DM, G, bid);
                pg8::EpiF32 E{HRAW};
                pg8::gemm_phase<pg8::EpiF32>(tid, lds3, g, S, E);
            } break;
            case 2:
                norm_phase(xin, a.out, HRAW, a.in[I_F1POST] + l * DM, 0.5f, a.in[I_MPRE] + l * DM, XB, gw, NGW, lane);
                break;
            case 3: {
                pg8::Gemm g{XB, (const bf16_t*)(ws + W_IN), MTOK, INW, DM}; pg8::StaticOrder S; S.init(MTOK, INW, G, bid);
                pg8::EpiMix E{Pb, a.in[I_BGATE] + l * 3 * DM};
                pg8::gemm_phase<pg8::EpiMix>(tid, lds3, g, S, E);
            } break;
            case 4:
                attn_phase(tid, bid, G, lds, Pb, BR);
                pool_phase(tid, bid, G, lds, Pb, BR, a.in[I_POOLW] + l * 4 * 4096, a.in[I_POOLS] + l * 256);
                conv_phase(tid, bid, G, Pb, BR, a.in[I_CONVW] + l * 3 * 256, a.in[I_CONVB] + l * 256);
                break;
            case 5: {
                pg8::Gemm g{BR, (const bf16_t*)(ws + W_BR), MTOK, DM, DM}; pg8::StaticOrder S; S.init(MTOK, DM, G, bid);
                pg8::EpiMerged E{XB, Pb + OFF_GATE};
                pg8::gemm_phase<pg8::EpiMerged>(tid, lds3, g, S, E);
            } break;
            case 6: {
                pg8::Gemm g{XB, (const bf16_t*)(ws + W_OUT), MTOK, DM, DM}; pg8::StaticOrder S; S.init(MTOK, DM, G, bid);
                pg8::EpiF32 E{HRAW};
                pg8::gemm_phase<pg8::EpiF32>(tid, lds3, g, S, E);
            } break;
            case 7:
                norm_phase(xin, a.out, HRAW, a.in[I_MPOST] + l * DM, 1.0f, a.in[I_F2PRE] + l * DM, XB, gw, NGW, lane);
                break;
            case 10:
                norm_phase(xin, a.out, HRAW, a.in[I_F2POST] + l * DM, 0.5f, (l + 1 < DEPTH) ? a.in[I_F1PRE] + (l + 1) * DM : nullptr, XB, gw, NGW, lane);
                if (l + 1 < DEPTH) { __syncthreads(); convert_weights(a, l + 1, lds, gw, NGW, wave, lane); }
                break;
            default: break;
            }
        }
#if PROBE_REP
        if (ph > 0 && ((PROBE_REP >> ((ph - 1) % 11)) & 1) && rep == 0) { rep = 1; __syncthreads(); continue; }
        rep = 0;
#endif
        if (ph + 1 < a.ph_hi) { __syncthreads(); grid.sync(); }
        ++ph;
    }
}

extern "C" void kernel_launch(void* const* d_in, const int* in_sizes, int n_in, void* d_out, int out_size, void* d_ws, size_t ws_size, hipStream_t stream) {
    static int grid_blocks = 0;
    if (grid_blocks == 0) {
        if (n_in != 23 || out_size != MTOK * DM || ws_size < WS_NEED) {
            fprintf(stderr, "kernel_launch: unexpected problem (n_in %d, out %d, ws %zu, need %zu)\n", n_in, out_size, ws_size, (size_t)WS_NEED);
            grid_blocks = -1; return;
        }
        int dev = 0, cus = 0, per_cu = 0;
        hipGetDevice(&dev);
        hipDeviceGetAttribute(&cus, hipDeviceAttributeMultiprocessorCount, dev);
        hipFuncSetAttribute((const void*)fwd_megakernel, hipFuncAttributeMaxDynamicSharedMemorySize, LDS_BYTES);
        if (hipOccupancyMaxActiveBlocksPerMultiprocessor(&per_cu, (const void*)fwd_megakernel, 512, LDS_BYTES) != hipSuccess || per_cu < 1) per_cu = 1;
        (void)hipGetLastError();
        if (per_cu > 1) per_cu = 1;
        grid_blocks = cus * per_cu;
    }
    if (grid_blocks < 0) return;
    Args a{};
    for (int i = 0; i < 23; ++i) a.in[i] = (const float*)d_in[i];
    a.out = (float*)d_out; a.ws = (unsigned char*)d_ws;
#if MULTI_LAUNCH
    for (int ph = 0; ph < NPHASE; ++ph) {
        a.ph_lo = ph; a.ph_hi = ph + 1;
        hipLaunchKernelGGL(fwd_megakernel, dim3(grid_blocks), dim3(512), LDS_BYTES, stream, a);
    }
#else
    a.ph_lo = 0; a.ph_hi = NPHASE;
    void* args[] = {&a};
    hipError_t e = hipLaunchCooperativeKernel((const void*)fwd_megakernel, dim3(grid_blocks), dim3(512), args, LDS_BYTES, stream);
    if (e != hipSuccess) fprintf(stderr, "cooperative launch failed: %s (grid %d)\n", hipGetErrorString(e), grid_blocks);
#endif
}
```
